# Optimizing an MI355X kernel written in HIP

```python
import math
import jax, jax.numpy as jnp
from jax import lax
import numpy as np

D_MODEL = 2048
BATCH = 4
SEQ = 4096
DEPTH = 2

HEAD_DIM = 128
MIX_WIDTH = D_MODEL
ATTN_HEADS = (MIX_WIDTH // 2) // HEAD_DIM
ATTN_WIDTH = ATTN_HEADS * HEAD_DIM
GMLP_WIDTH = MIX_WIDTH - ATTN_WIDTH
GMLP_GROUPS = 8
GMLP_GROUP_DIM = GMLP_WIDTH // GMLP_GROUPS
CHUNK = 128
DILATED_BRANCHES = ((128, 1), (512, 4), (2048, 16))
ROPE_THETA = 10000.0
D_FF = 4 * D_MODEL
NORM_EPS = 1e-6
LN_EPS = 1e-5
IN_WIDTH = 3 * ATTN_WIDTH + 2 * GMLP_WIDTH

kernel_name = "hybrid_dilated_attn_gmlp_trunk"


def rms_norm(x, g):
    xf = x.astype(jnp.float32)
    y = xf * lax.rsqrt(jnp.mean(xf * xf, axis=-1, keepdims=True) + NORM_EPS)
    return (y * g.astype(jnp.float32)).astype(x.dtype)


def layer_norm(x, g, b):
    xf = x.astype(jnp.float32)
    mu = jnp.mean(xf, axis=-1, keepdims=True)
    xc = xf - mu
    var = jnp.mean(xc * xc, axis=-1, keepdims=True)
    y = xc * lax.rsqrt(var + LN_EPS) * g.astype(jnp.float32) + b.astype(jnp.float32)
    return y.astype(x.dtype)


def rotary(x, pos):
    half = HEAD_DIM // 2
    inv_freq = ROPE_THETA ** (-jnp.arange(half, dtype=jnp.float32) / half)
    ang = pos.astype(jnp.float32)[:, None] * inv_freq[None, :]
    cos = jnp.cos(ang)[None, :, None, :]
    sin = jnp.sin(ang)[None, :, None, :]
    xf = x.astype(jnp.float32)
    x1, x2 = xf[..., :half], xf[..., half:]
    return jnp.concatenate([x1 * cos - x2 * sin, x2 * cos + x1 * sin], axis=-1).astype(x.dtype)


def dilated_branch(q, k, v, window, dilation):
    B, S, H, Dh = q.shape
    blk = window // dilation
    span = dilation * blk
    s_pad = -(-S // span) * span
    nb = s_pad // span
    pad = ((0, 0), (0, s_pad - S), (0, 0), (0, 0))

    def blocks(t):
        return jnp.pad(t, pad).reshape(B, nb, blk, dilation, H, Dh)

    def with_prev(t):
        prev = jnp.concatenate([jnp.zeros_like(t[:, :1]), t[:, :-1]], axis=1)
        return jnp.concatenate([prev, t], axis=2)

    qb = blocks(q)
    kc = with_prev(blocks(k))
    vc = with_prev(blocks(v))
    scores = jnp.einsum('bnqrhd,bnkrhd->bnrhqk', qb, kc,
                        preferred_element_type=jnp.float32) * (Dh ** -0.5)
    qi = jnp.arange(blk)[:, None]
    kj = jnp.arange(2 * blk)[None, :]
    dist = qi - kj + blk
    key_idx = jnp.arange(nb)[:, None, None] * blk - blk + kj[None]
    valid = (dist >= 0)[None] & (dist <= blk)[None] & (key_idx >= 0)
    scores = jnp.where(valid[None, :, None, None], scores, -jnp.inf)
    m = jnp.max(scores, axis=-1, keepdims=True)
    p = jnp.exp(scores - m)
    l = jnp.sum(p, axis=-1, keepdims=True)
    o = jnp.einsum('bnrhqk,bnkrhd->bnqrhd', p / l, vc.astype(jnp.float32))
    lse = jnp.transpose((m + jnp.log(l))[..., 0], (0, 1, 4, 2, 3))
    o = o.reshape(B, s_pad, H, Dh)[:, :S]
    lse = lse.reshape(B, s_pad, H)[:, :S]
    return o, lse


def dilated_attention(q, k, v):
    outs, lses = [], []
    for window, dilation in DILATED_BRANCHES:
        o, lse = dilated_branch(q, k, v, window, dilation)
        outs.append(o)
        lses.append(lse)
    w = jax.nn.softmax(jnp.stack(lses, axis=0), axis=0)
    return jnp.einsum('nbsh,nbshd->bshd', w, jnp.stack(outs, axis=0))


def chunked_gmlp(u, v, ln_g, ln_b, w_s, b_s):
    B, S, _ = u.shape
    nc = S // CHUNK
    v = layer_norm(v.reshape(B, S, GMLP_GROUPS, GMLP_GROUP_DIM), ln_g, ln_b)
    v = v.reshape(B, nc, CHUNK, GMLP_GROUPS, GMLP_GROUP_DIM)
    causal = jnp.tril(jnp.ones((CHUNK, CHUNK), dtype=w_s.dtype))
    sp = jnp.einsum('gts,bcsgd->bctgd', w_s * causal[None], v) \
        + jnp.transpose(b_s)[None, None, :, :, None]
    out = u.reshape(B, nc, CHUNK, GMLP_GROUPS, GMLP_GROUP_DIM) * sp
    return out.reshape(B, S, GMLP_WIDTH)


def setup_inputs(seed: int = 0) -> dict:
    key = jax.random.key(seed)
    ks = jax.random.split(key, 13)
    f32 = jnp.float32
    nrm = lambda k, shape, s: jax.random.normal(k, shape, f32) * s
    return {
        "x": nrm(ks[0], (BATCH, SEQ, D_MODEL), 1.0),
        "norm1_g": 1.0 + nrm(ks[1], (DEPTH, D_MODEL), 0.02),
        "w_in": nrm(ks[2], (DEPTH, D_MODEL, IN_WIDTH), D_MODEL ** -0.5),
        "gmlp_ln_g": 1.0 + nrm(ks[3], (DEPTH, GMLP_GROUPS, GMLP_GROUP_DIM), 0.02),
        "gmlp_ln_b": nrm(ks[4], (DEPTH, GMLP_GROUPS, GMLP_GROUP_DIM), 0.02),
        "w_spatial": nrm(ks[5], (DEPTH, GMLP_GROUPS, CHUNK, CHUNK), CHUNK ** -0.5),
        "b_spatial": 1.0 + nrm(ks[6], (DEPTH, GMLP_GROUPS, CHUNK), 0.1),
        "w_out": nrm(ks[7], (DEPTH, MIX_WIDTH, D_MODEL), MIX_WIDTH ** -0.5),
        "norm2_g": 1.0 + nrm(ks[8], (DEPTH, D_MODEL), 0.02),
        "w_up": nrm(ks[9], (DEPTH, D_MODEL, D_FF), D_MODEL ** -0.5),
        "w_down": nrm(ks[10], (DEPTH, D_FF, D_MODEL), D_FF ** -0.5),
        "final_g": 1.0 + nrm(ks[11], (D_MODEL,), 0.02),
    }


def reference(x, norm1_g, w_in, gmlp_ln_g, gmlp_ln_b, w_spatial, b_spatial,
              w_out, norm2_g, w_up, w_down, final_g):
    B, S, _ = x.shape
    pos = jnp.arange(S, dtype=jnp.int32)
    splits = [ATTN_WIDTH, 2 * ATTN_WIDTH, 3 * ATTN_WIDTH, 3 * ATTN_WIDTH + GMLP_WIDTH]
    for l in range(DEPTH):
        h = rms_norm(x, norm1_g[l])
        z = h @ w_in[l]
        q, k, v, gu, gv = jnp.split(z, splits, axis=-1)
        heads = (B, S, ATTN_HEADS, HEAD_DIM)
        q = rotary(q.reshape(heads), pos)
        k = rotary(k.reshape(heads), pos)
        attn = dilated_attention(q, k, v.reshape(heads)).reshape(B, S, ATTN_WIDTH)
        gm = chunked_gmlp(jax.nn.gelu(gu), jax.nn.gelu(gv), gmlp_ln_g[l], gmlp_ln_b[l],
                          w_spatial[l], b_spatial[l])
        mix = jnp.concatenate([attn.astype(x.dtype), gm.astype(x.dtype)], axis=-1)
        x = x + mix @ w_out[l]
        h2 = rms_norm(x, norm2_g[l])
        x = x + jnp.square(jax.nn.relu(h2 @ w_up[l])) @ w_down[l]
    return rms_norm(x, final_g)
```

```cpp
#include <hip/hip_runtime.h>
#include <hip/hip_cooperative_groups.h>
#include <cstdio>
#include <cstdint>
namespace cg = cooperative_groups;
namespace pg8 {
#define PG8_LAS __attribute__((address_space(3)))
typedef unsigned short bf16_t;
typedef short bf16x8 __attribute__((ext_vector_type(8)));
typedef float f32x4 __attribute__((ext_vector_type(4)));
typedef unsigned u32x4 __attribute__((ext_vector_type(4)));


__device__ __forceinline__ int fresh_lane() { int l; asm volatile("v_mbcnt_lo_u32_b32 %0, -1, 0\n\tv_mbcnt_hi_u32_b32 %0, -1, %0" : "=v"(l)); return l; }
__device__ __forceinline__ float lane_xor1(float v) { return __shfl_xor(v, 1); }
__device__ __forceinline__ float lane_xor2(float v) { return __shfl_xor(v, 2); }
__device__ __forceinline__ float lane_xor16(float v) { return __builtin_bit_cast(float, __builtin_amdgcn_ds_swizzle(__builtin_bit_cast(int, v), 0x401F)); }
__device__ __forceinline__ float sum_16_32(float v) { v += __shfl_xor(v, 16); v += __shfl_xor(v, 32); return v; }
__device__ __forceinline__ float max_16_32(float v) { v = fmaxf(v, __shfl_xor(v, 16)); v = fmaxf(v, __shfl_xor(v, 32)); return v; }
constexpr int BM = 256, BK = 64, HALF = 128, HTB = HALF * BK * 2  , STAGE_BYTES = 8 * HTB, NXCD = 8, WGM = 4;

__host__ __device__ __forceinline__ int lds_byte(int r, int c) { const int st = (r >> 4) * 2 + (c >> 5), rr = r & 15, cc = c & 31, ob = rr * 64 + cc * 2; return st * 1024 + (ob ^ (((ob >> 9) & 1) << 5)); }
__host__ __device__ __forceinline__ void stage_rc(int b, int& R, int& C) { const int st = b / 1024, sb = b % 1024, swz = sb ^ (((sb >> 9) & 1) << 5); R = (st >> 1) * 16 + swz / 64; C = (st & 1) * 32 + (swz % 64) / 2; }
__host__ __device__ __forceinline__ int perm32(int rho) { const int n = rho >> 4, i = rho & 15; return 8 * (i >> 2) + 4 * n + (i & 3); }

struct Unit { int pm, pn; };
struct Gemm { const bf16_t* A; const bf16_t* Bt; int M, N, K, lda; };

struct StaticOrder {
    int nM, nN, nwg, G, c, wgm;
    __host__ __device__ void init(int M, int N, int G_, int c_, int wgm_ = WGM) { nM = M / BM; nN = N / BM; nwg = nM * nN; G = G_; c = c_; wgm = wgm_; }
    __host__ __device__ bool next(int i, Unit& u) const {
        const long L = (long)i * G + c; if (L >= nwg) return false;
        int wgid = (int)L; { const int q = nwg / NXCD, r = nwg % NXCD, xcd = wgid % NXCD, off = wgid / NXCD; wgid = (xcd < r ? xcd * (q + 1) : r * (q + 1) + (xcd - r) * q) + off; }
        const int nig = wgm * nN, gid = wgid / nig, fm = gid * wgm, gsz = (nM - fm) < wgm ? (nM - fm) : wgm;
        u.pm = fm + ((wgid % nig) % gsz); u.pn = (wgid % nig) / gsz; return true;
    }
    __device__ __forceinline__ void a_ready(const Unit&) const {}
    __device__ __forceinline__ void done(const Unit&) const {}
};

__device__ __forceinline__ unsigned cvt_pk_bf16(float lo, float hi) { unsigned r; asm volatile("v_cvt_pk_bf16_f32 %0, %1, %2" : "=v"(r) : "v"(lo), "v"(hi)); return r; }
typedef float f32x2 __attribute__((ext_vector_type(2)));
__device__ __forceinline__ f32x2 gelu_pk(f32x2 v) {
    const f32x2 av = __builtin_elementwise_abs(v), d = av * 0.2316418882f + 1.0f;
    f32x2 t; t.x = __builtin_amdgcn_rcpf(d.x); t.y = __builtin_amdgcn_rcpf(d.y);
    f32x2 q = t * 0.5307027145f + (-0.7265760135f); q = q * t + 0.7107068705f; q = q * t + (-0.142248368f); q = q * t + 0.127414796f; q = q * t;
    const f32x2 s = (v * v) * (-0.72134752044f);
    f32x2 e; e.x = __builtin_amdgcn_exp2f(s.x); e.y = __builtin_amdgcn_exp2f(s.y);
    const f32x2 m = v * (q * e), r = v - m;
    f32x2 o; o.x = v.x < 0.f ? m.x : r.x; o.y = v.y < 0.f ? m.y : r.y; return o;
}


__device__ __forceinline__ float gelu_tanh(float x) {
    const float y = x * (0.7978845608028654f + 0.7978845608028654f * 0.044715f * x * x);
    const float e = __builtin_amdgcn_exp2f(-2.0f * 1.4426950408889634f * y);
    return x * __builtin_amdgcn_rcpf(1.0f + e);
}


#define EPI_FENCE() asm volatile("" ::: "memory")
struct RsTable { int pm[4]; const PG8_LAS float* tab; };
template <class Sched>
__device__ __forceinline__ RsTable rs_prepass(PG8_LAS unsigned char* lds_spare, const float* ssp, const Sched& S, int tid) {
    RsTable T; T.pm[0] = T.pm[1] = T.pm[2] = T.pm[3] = -1; T.tab = (const PG8_LAS float*)(lds_spare + 4096);
    Unit u;
    for (int i = 0; S.next(i, u); ++i) { if (u.pm == T.pm[0] || u.pm == T.pm[1] || u.pm == T.pm[2] || u.pm == T.pm[3]) continue;
        if (T.pm[0] < 0) T.pm[0] = u.pm; else if (T.pm[1] < 0) T.pm[1] = u.pm; else if (T.pm[2] < 0) T.pm[2] = u.pm; else T.pm[3] = u.pm; }
    PG8_LAS float* part = (PG8_LAS float*)lds_spare;
    PG8_LAS float* tab = (PG8_LAS float*)(lds_spare + 4096);
    const int row = tid & 255, half = tid >> 8;
#pragma unroll
    for (int k = 0; k < 4; ++k) {
        if (T.pm[k] < 0) continue;
        const float* p = ssp + (size_t)(16 * half) * 16384 + T.pm[k] * 256 + row; float s = 0.f;
#pragma unroll
        for (int q = 0; q < 16; ++q) s += p[(size_t)q * 16384];
        part[half * 256 + row] = s;
        __syncthreads();
        if (half == 0) tab[k * 256 + row] = rsqrtf((part[row] + part[256 + row]) * (1.0f / 2048.0f) + 1e-6f);
        __syncthreads();
    }
    return T;
}
__device__ __forceinline__ void load_rs(float (&rs)[8], const RsTable& T, int pm, int lrow0) {
    const int k = pm == T.pm[0] ? 0 : (pm == T.pm[1] ? 1 : (pm == T.pm[2] ? 2 : 3));
#pragma unroll
    for (int i = 0; i < 8; ++i) rs[i] = T.tab[k * 256 + lrow0 + (i >> 2) * HALF + (i & 3) * 16];
}

struct EpiInProj {
    static constexpr bool PERM = true, AFTER_DRAIN = false;
    __device__ __forceinline__ void init(f32x4 (&acc)[2][2][4][2], const Unit&, int, int, int, int) const {
#pragma unroll
        for (int a = 0; a < 2; ++a)
#pragma unroll
            for (int b = 0; b < 2; ++b)
#pragma unroll
                for (int m = 0; m < 4; ++m)
#pragma unroll
                    for (int n = 0; n < 2; ++n) acc[a][b][m][n] = (f32x4){0.f, 0.f, 0.f, 0.f};
    }
    bf16_t* Z; const float* rope; RsTable rst;
    __device__ __forceinline__ void operator()(const f32x4 (&acc)[2][2][4][2], const Unit& u, int wr, int wc, int fr, int fq) const {
        const int row0 = u.pm * BM + wr * 64 + fr; const int col0 = u.pn * BM + wc * 32 + 8 * fq;
        const int kind = u.pn >= 12 ? 2 : ((u.pn >> 2) == 1 ? 1 : 0);
        const float qs = u.pn >= 8 ? 0.12751743082459868f : 1.0f;
        const int j0 = 16 * wc + 4 * fq;
        float rs[8]; load_rs(rs, rst, u.pm, wr * 64 + fr);
        if (kind == 0) {
#pragma unroll
            for (int ai = 0; ai < 2; ++ai) {
                f32x4 cs[4][2];
#pragma unroll
                for (int m = 0; m < 4; ++m) { const int row = row0 + ai * HALF + m * 16; const f32x4* rp = (const f32x4*)(rope + ((size_t)(row & 4095) * 64 + j0) * 2); cs[m][0] = rp[0]; cs[m][1] = rp[1]; }
                EPI_FENCE();
#pragma unroll
                for (int m = 0; m < 4; ++m) {
                    bf16_t* rowp = Z + (size_t)(row0 + ai * HALF + m * 16) * 5120 + col0;
                    const float sc = rs[4 * ai + m] * qs; const f32x4 c0 = cs[m][0] * sc, c1 = cs[m][1] * sc;
#pragma unroll
                    for (int bj = 0; bj < 2; ++bj) {
                        const f32x4 v0 = acc[ai][bj][m][0], v1 = acc[ai][bj][m][1];
                        u32x4 w;
                        w.x = cvt_pk_bf16(v0[0] * c0[0] - v0[1] * c0[1], v0[1] * c0[0] + v0[0] * c0[1]);
                        w.y = cvt_pk_bf16(v0[2] * c0[2] - v0[3] * c0[3], v0[3] * c0[2] + v0[2] * c0[3]);
                        w.z = cvt_pk_bf16(v1[0] * c1[0] - v1[1] * c1[1], v1[1] * c1[0] + v1[0] * c1[1]);
                        w.w = cvt_pk_bf16(v1[2] * c1[2] - v1[3] * c1[3], v1[3] * c1[2] + v1[2] * c1[3]);
                        *(u32x4*)(rowp + bj * HALF) = w;
                    }
                }
                EPI_FENCE();
            }
        } else {
            EPI_FENCE();
#pragma unroll
            for (int i = 0; i < 8; ++i) {
                const int ai = i >> 2, m = i & 3; bf16_t* rowp = Z + (size_t)(row0 + ai * HALF + m * 16) * 5120 + col0;
#pragma unroll
                for (int bj = 0; bj < 2; ++bj) {
                    f32x4 v0 = acc[ai][bj][m][0] * rs[i], v1 = acc[ai][bj][m][1] * rs[i];
                    if (kind == 2) {
#pragma unroll
                        for (int e = 0; e < 4; ++e) { v0[e] = gelu_tanh(v0[e]); v1[e] = gelu_tanh(v1[e]); }
                    }
                    u32x4 w; w.x = cvt_pk_bf16(v0[0], v0[1]); w.y = cvt_pk_bf16(v0[2], v0[3]); w.z = cvt_pk_bf16(v1[0], v1[1]); w.w = cvt_pk_bf16(v1[2], v1[3]);
                    *(u32x4*)(rowp + bj * HALF) = w;
                }
            }
        }
    }
};

struct EpiRelu2 {
    static constexpr bool PERM = true, AFTER_DRAIN = false;
    __device__ __forceinline__ void init(f32x4 (&acc)[2][2][4][2], const Unit&, int, int, int, int) const {
#pragma unroll
        for (int a = 0; a < 2; ++a)
#pragma unroll
            for (int b = 0; b < 2; ++b)
#pragma unroll
                for (int m = 0; m < 4; ++m)
#pragma unroll
                    for (int n = 0; n < 2; ++n) acc[a][b][m][n] = (f32x4){0.f, 0.f, 0.f, 0.f};
    }
    bf16_t* O; int ldc; RsTable rst;
    __device__ __forceinline__ void operator()(const f32x4 (&acc)[2][2][4][2], const Unit& u, int wr, int wc, int fr, int fq) const {
        const int row0 = u.pm * BM + wr * 64 + fr; const int col0 = u.pn * BM + wc * 32 + 8 * fq;
        float rs[8]; load_rs(rs, rst, u.pm, wr * 64 + fr);
        EPI_FENCE();
#pragma unroll
        for (int i = 0; i < 8; ++i) { const int ai = i >> 2, m = i & 3; bf16_t* rowp = O + (size_t)(row0 + ai * HALF + m * 16) * ldc + col0;
#pragma unroll
            for (int bj = 0; bj < 2; ++bj) { f32x4 v0 = acc[ai][bj][m][0] * rs[i], v1 = acc[ai][bj][m][1] * rs[i];
#pragma unroll
                for (int e = 0; e < 4; ++e) { const float a = fmaxf(v0[e], 0.f), b = fmaxf(v1[e], 0.f); v0[e] = a * a; v1[e] = b * b; }
                u32x4 w; w.x = cvt_pk_bf16(v0[0], v0[1]); w.y = cvt_pk_bf16(v0[2], v0[3]); w.z = cvt_pk_bf16(v1[0], v1[1]); w.w = cvt_pk_bf16(v1[2], v1[3]);
                *(u32x4*)(rowp + bj * HALF) = w; } }
    }
};

struct EpiResid {
    static constexpr bool PERM = true, AFTER_DRAIN = false;
    float* out; bf16_t* xb; float* ss; int wf32;
    static constexpr unsigned LDC = 2048;
    __device__ __forceinline__ static float blo(unsigned w) { return __builtin_bit_cast(float, w << 16); }
    __device__ __forceinline__ static float bhi(unsigned w) { return __builtin_bit_cast(float, w & 0xffff0000u); }
    __device__ __forceinline__ void init(f32x4 (&acc)[2][2][4][2], const Unit& u, int wr, int wc, int fr, int fq) const {
        const int row0 = u.pm * BM + wr * 64 + fr; const int col0 = u.pn * BM + wc * 32 + 8 * fq;
        const unsigned ob0 = ((unsigned)row0 * LDC + (unsigned)col0) * 2u; const char* bb = (const char*)xb;
#pragma unroll
        for (int ai = 0; ai < 2; ++ai)
#pragma unroll
            for (int m = 0; m < 4; ++m) { const unsigned o = ob0 + (unsigned)((ai * HALF + m * 16) * LDC * 2);
#pragma unroll
                for (int bj = 0; bj < 2; ++bj) { const u32x4 w = *(const u32x4*)(bb + o + bj * HALF * 2);
                    acc[ai][bj][m][0] = (f32x4){blo(w.x), bhi(w.x), blo(w.y), bhi(w.y)}; acc[ai][bj][m][1] = (f32x4){blo(w.z), bhi(w.z), blo(w.w), bhi(w.w)}; } }
    }
    __device__ __forceinline__ void operator()(const f32x4 (&acc)[2][2][4][2], const Unit& u, int wr, int wc, int fr, int fq) const {
        const int row0 = u.pm * BM + wr * 64 + fr; const int col0 = u.pn * BM + wc * 32 + 8 * fq;
        const unsigned ob0 = ((unsigned)row0 * LDC + (unsigned)col0) * 4u;
        char* ob = (char*)out; char* xbb = (char*)xb;
#pragma unroll
        for (int ai = 0; ai < 2; ++ai) { float sm[4];
#pragma unroll
            for (int m = 0; m < 4; ++m) { const unsigned o = ob0 + (unsigned)((ai * HALF + m * 16) * LDC * 4); float s = 0.f;
#pragma unroll
                for (int bj = 0; bj < 2; ++bj) {
                    const f32x4 o0 = acc[ai][bj][m][0], o1 = acc[ai][bj][m][1];
                    s += (o0[0] * o0[0] + o0[1] * o0[1]) + (o0[2] * o0[2] + o0[3] * o0[3]) + (o1[0] * o1[0] + o1[1] * o1[1]) + (o1[2] * o1[2] + o1[3] * o1[3]);
                    if (wf32) { *(f32x4*)(ob + o + bj * HALF * 4) = o0; *(f32x4*)(ob + o + bj * HALF * 4 + 16) = o1; }
                    else { u32x4 w; w.x = cvt_pk_bf16(o0[0], o0[1]); w.y = cvt_pk_bf16(o0[2], o0[3]); w.z = cvt_pk_bf16(o1[0], o1[1]); w.w = cvt_pk_bf16(o1[2], o1[3]);
                           *(u32x4*)(xbb + (o >> 1) + bj * HALF * 2) = w; } }
                s = sum_16_32(s);
                sm[m] = s; }
            ss[(size_t)(4 * u.pn + wc) * 16384 + u.pm * BM + wr * 64 + ai * HALF + 16 * fq + fr] = fq == 0 ? sm[0] : (fq == 1 ? sm[1] : (fq == 2 ? sm[2] : sm[3])); }
    }
};
template <class Epi, class Sched, bool ALIGN_EPI = false, bool SP2 = false>
__device__ __forceinline__ void gemm_phase(PG8_LAS unsigned char* lds, const Gemm g, const Sched& S, const Epi& E, const int wid_in) {
    int wid = wid_in; asm volatile("" : "+s"(wid));
    const int lane_ = fresh_lane();
    const int lane = lane_, tid = wid * 64 + lane,
               wr = wid >> 2, wc = wid & 3, fr = lane & 15, fq = lane >> 4;
    const int K = g.K, nt = K / BK;
    unsigned voffA[2], voffB[2];
#pragma unroll
    for (int i = 0; i < 2; ++i) { int R, C; stage_rc(tid * 16 + i * 8192, R, C); const int Rb = Epi::PERM ? ((R & ~31) + perm32(R & 31)) : R;
        voffA[i] = (unsigned)(R * g.lda + C) * 2u; voffB[i] = (unsigned)(Rb * K + C) * 2u; }
    const size_t kstep = (size_t)(BK * 2);
    const size_t hstep = (size_t)HALF * K * 2, tstep = 2 * hstep;
    const size_t hstepA = (size_t)HALF * g.lda * 2, tstepA = 2 * hstepA;
    const unsigned ldsw = (unsigned)wid * 1024u;
    const int aoff = lds_byte(wr * 64 + fr, fq * 8), boff = lds_byte(wc * 32 + fr, fq * 8);
#define PG8_SA(b, h) (((b) * 2 + (h)) * HTB)
#define PG8_SB(b, h) ((4 + (b) * 2 + (h)) * HTB)
#define PG8_STAGE(bufoff, gbase, voff) do { _Pragma("unroll") for (int _i = 0; _i < 2; ++_i) \
        __builtin_amdgcn_global_load_lds((const unsigned*)((const char*)(gbase) + (voff)[_i]), (PG8_LAS unsigned*)(lds + (bufoff) + ldsw + _i * 8192), 16, 0, 0); } while (0)
#define PG8_LDA(dst, b, h) do { _Pragma("unroll") for (int m = 0; m < 4; ++m) _Pragma("unroll") for (int k = 0; k < 2; ++k) dst[m][k] = *(const PG8_LAS bf16x8*)(lds + PG8_SA(b, h) + aoff + m * 2048 + k * 1024); } while (0)
#define PG8_LDB(dst, b, h) do { _Pragma("unroll") for (int n = 0; n < 2; ++n) _Pragma("unroll") for (int k = 0; k < 2; ++k) dst[n][k] = *(const PG8_LAS bf16x8*)(lds + PG8_SB(b, h) + boff + n * 2048 + k * 1024); } while (0)
#define PG8_MMA(ai, bj, At, Bt) do { __builtin_amdgcn_s_setprio(1); _Pragma("unroll") for (int m = 0; m < 4; ++m) _Pragma("unroll") for (int n = 0; n < 2; ++n) _Pragma("unroll") for (int k = 0; k < 2; ++k) \
        acc[ai][bj][m][n] = __builtin_amdgcn_mfma_f32_16x16x32_bf16(Bt[n][k], At[m][k], acc[ai][bj][m][n], 0, 0, 0); __builtin_amdgcn_s_setprio(0); } while (0)
#define PG8_WAIT_V(n) asm volatile("s_waitcnt vmcnt(" #n ")" ::: "memory")
#define PG8_WAIT_L(n) asm volatile("s_waitcnt lgkmcnt(" #n ")" ::: "memory")
#define PG8_BAR __builtin_amdgcn_s_barrier()
#define PG8_SCHED __builtin_amdgcn_sched_barrier(0)
    Unit cur, nxt; int ui = 0;
    if (!S.next(0, cur)) return;
    f32x4 acc[2][2][4][2];
    E.init(acc, cur, wr, wc, fr, fq);
    bf16x8 At[4][2], B0[2][2], B1[2][2];
    const char* cA = (const char*)g.A + (size_t)cur.pm * tstepA; const char* cB = (const char*)g.Bt + (size_t)cur.pn * tstep;
    S.a_ready(cur);
    if constexpr (SP2) {
        PG8_STAGE(PG8_SB(0, 0), cB, voffB); PG8_STAGE(PG8_SB(0, 1), cB + hstep, voffB); PG8_STAGE(PG8_SA(0, 0), cA, voffA); PG8_STAGE(PG8_SA(0, 1), cA + hstepA, voffA);
        if (wr == 1) PG8_BAR;
        PG8_WAIT_V(2); PG8_BAR;
        PG8_STAGE(PG8_SB(1, 0), cB + kstep, voffB); PG8_STAGE(PG8_SA(1, 0), cA + kstep, voffA); PG8_STAGE(PG8_SB(1, 1), cB + hstep + kstep, voffB);
        PG8_WAIT_V(6); PG8_BAR;
    } else {
        PG8_STAGE(PG8_SB(0, 0), cB, voffB); PG8_STAGE(PG8_SA(0, 0), cA, voffA); PG8_STAGE(PG8_SB(0, 1), cB + hstep, voffB); PG8_STAGE(PG8_SA(0, 1), cA + hstepA, voffA);
        if (wr == 1) PG8_BAR;
        PG8_WAIT_V(4); PG8_BAR;
        PG8_STAGE(PG8_SB(1, 0), cB + kstep, voffB); PG8_STAGE(PG8_SA(1, 0), cA + kstep, voffA); PG8_STAGE(PG8_SB(1, 1), cB + hstep + kstep, voffB);
        PG8_WAIT_V(6); PG8_BAR;
    }
    for (;;) {
        const bool has_next = S.next(ui + 1, nxt);
        const char* nA = has_next ? (const char*)g.A + (size_t)nxt.pm * tstepA : cA; const char* nB = has_next ? (const char*)g.Bt + (size_t)nxt.pn * tstep : cB;
        for (int t = 0; t < nt; t += 2) {
            const bool last = (t == nt - 2);
            const char* a1 = cA + (size_t)(t + 1) * kstep;
            const char* a2 = last ? nA : cA + (size_t)(t + 2) * kstep; const char* b2 = last ? nB : cB + (size_t)(t + 2) * kstep;
            const char* a3 = a2 + kstep; const char* b3 = b2 + kstep;
            if (last && has_next) S.a_ready(nxt);
            if constexpr (SP2) {
            PG8_LDB(B0, 0, 0); PG8_LDB(B1, 0, 1); PG8_SCHED; PG8_LDA(At, 0, 0); PG8_STAGE(PG8_SA(1, 1), a1 + hstepA, voffA);
            PG8_WAIT_V(8); PG8_WAIT_L(0); PG8_BAR; PG8_MMA(0, 0, At, B0); PG8_MMA(0, 1, At, B1); PG8_BAR; PG8_SCHED;
            PG8_LDA(At, 0, 1); PG8_STAGE(PG8_SB(0, 0), b2, voffB); PG8_STAGE(PG8_SB(0, 1), b2 + hstep, voffB); PG8_STAGE(PG8_SA(0, 0), a2, voffA);
            PG8_WAIT_V(8); PG8_WAIT_L(0); PG8_BAR; PG8_MMA(1, 0, At, B0); PG8_MMA(1, 1, At, B1); PG8_BAR; PG8_SCHED;
            PG8_LDB(B0, 1, 0); PG8_LDB(B1, 1, 1); PG8_SCHED; PG8_LDA(At, 1, 0); PG8_STAGE(PG8_SA(0, 1), a2 + hstepA, voffA);
            PG8_WAIT_V(8); PG8_WAIT_L(0); PG8_BAR; PG8_MMA(0, 0, At, B0); PG8_MMA(0, 1, At, B1); PG8_BAR; PG8_SCHED;
            PG8_LDA(At, 1, 1); PG8_STAGE(PG8_SB(1, 0), b3, voffB); PG8_STAGE(PG8_SB(1, 1), b3 + hstep, voffB); PG8_STAGE(PG8_SA(1, 0), a3, voffA);
            PG8_WAIT_V(8); PG8_WAIT_L(0); PG8_BAR; PG8_MMA(1, 0, At, B0); PG8_MMA(1, 1, At, B1); PG8_BAR; PG8_SCHED;
            } else {
            PG8_LDB(B0, 0, 0); PG8_SCHED; PG8_LDA(At, 0, 0); PG8_STAGE(PG8_SA(1, 1), a1 + hstepA, voffA);
            PG8_WAIT_L(8); PG8_BAR; PG8_WAIT_L(0); PG8_MMA(0, 0, At, B0); PG8_BAR; PG8_SCHED;
            PG8_LDB(B1, 0, 1); PG8_STAGE(PG8_SB(0, 0), b2, voffB);
            PG8_BAR; PG8_WAIT_L(0); PG8_MMA(0, 1, At, B1); PG8_BAR;
            PG8_LDA(At, 0, 1); PG8_STAGE(PG8_SA(0, 0), a2, voffA);
            PG8_BAR; PG8_WAIT_L(0); PG8_MMA(1, 0, At, B0); PG8_BAR; PG8_SCHED;
            PG8_STAGE(PG8_SB(0, 1), b2 + hstep, voffB);
            PG8_WAIT_V(6); PG8_BAR; PG8_MMA(1, 1, At, B1); PG8_BAR;
            PG8_LDB(B0, 1, 0); PG8_SCHED; PG8_LDA(At, 1, 0); PG8_STAGE(PG8_SA(0, 1), a2 + hstepA, voffA);
            PG8_WAIT_L(8); PG8_BAR; PG8_WAIT_L(0); PG8_MMA(0, 0, At, B0); PG8_BAR; PG8_SCHED;
            PG8_LDB(B1, 1, 1); PG8_STAGE(PG8_SB(1, 0), b3, voffB);
            PG8_BAR; PG8_WAIT_L(0); PG8_MMA(0, 1, At, B1); PG8_BAR;
            PG8_LDA(At, 1, 1); PG8_STAGE(PG8_SA(1, 0), a3, voffA);
            PG8_BAR; PG8_WAIT_L(0); PG8_MMA(1, 0, At, B0); PG8_BAR; PG8_SCHED;
            PG8_STAGE(PG8_SB(1, 1), b3 + hstep, voffB);
            PG8_WAIT_V(6); PG8_BAR; PG8_MMA(1, 1, At, B1); PG8_BAR;
            }
        }
        if constexpr (ALIGN_EPI) { if (wr == 0) PG8_BAR; }
        if constexpr (!Epi::AFTER_DRAIN) { E(acc, cur, wr, wc, fr, fq); S.done(cur); }
        if (!has_next) break;
        E.init(acc, nxt, wr, wc, fr, fq);
        cur = nxt; cA = nA; cB = nB; ++ui;
        if constexpr (ALIGN_EPI) { if (wr == 1) PG8_BAR; }
    }
    PG8_WAIT_V(0);
    if constexpr (!ALIGN_EPI) { if (wr == 0) PG8_BAR; }
    PG8_BAR;
    if constexpr (Epi::AFTER_DRAIN) { E.fused(acc, cur, wr, wc, fr, fq, lds, wid, lane); S.done(cur); }
#undef PG8_SA
#undef PG8_SB
#undef PG8_STAGE
#undef PG8_LDA
#undef PG8_LDB
#undef PG8_MMA
#undef PG8_WAIT_V
#undef PG8_WAIT_L
#undef PG8_BAR
#undef PG8_SCHED
}
}

constexpr int NWAVES = 8;
constexpr int BATCH = 4, SEQ = 4096, DM = 2048, DEPTH = 2, M = BATCH * SEQ;
constexpr int INW = 5120, DFF = 8192, HD = 128, NH = 8;
#ifndef WGM_IN
#define WGM_IN 4
#endif
#ifndef WGM_OUT
#define WGM_OUT 4
#endif
#ifndef WGM_UP
#define WGM_UP 4
#endif
#ifndef WGM_DN
#define WGM_DN 4
#endif
constexpr int LDS_MAIN = 147456, LDS_BYTES = LDS_MAIN + 64;

constexpr size_t MiB = 1u << 20;
constexpr size_t WS_WIN = 0;
constexpr size_t WS_WOUT = 40 * MiB;
constexpr size_t WS_WUP = 56 * MiB;
constexpr size_t WS_WDN = 120 * MiB;
constexpr size_t WS_ACT = 184 * MiB;
constexpr size_t WS_Z = 248 * MiB;
constexpr size_t WS_ON = 408 * MiB;
constexpr size_t WS_U = WS_Z;
constexpr size_t WS_LSE = 504 * MiB;
constexpr size_t WS_ROPE = 506 * MiB;
constexpr size_t WS_WSP = 508 * MiB;
constexpr size_t WS_BAR = 509 * MiB;
constexpr size_t WS_SS = 510 * MiB;
constexpr size_t WS_END = 512 * MiB;

#define LAS __attribute__((address_space(3)))
#define GAS1 __attribute__((address_space(1)))
typedef unsigned short bf16;
typedef unsigned v4u __attribute__((ext_vector_type(4)));
typedef unsigned v2u __attribute__((ext_vector_type(2)));
typedef float f32x4 __attribute__((ext_vector_type(4)));
typedef short bf16x8 __attribute__((ext_vector_type(8)));
typedef short s16x4 __attribute__((ext_vector_type(4)));
#define LDS_WAIT() asm volatile("s_waitcnt lgkmcnt(0)" ::: "memory")

__device__ __forceinline__ unsigned pk2(float lo, float hi) { return pg8::cvt_pk_bf16(lo, hi); }
__device__ __forceinline__ float bf_lo(unsigned w) { return __uint_as_float(w << 16); }
__device__ __forceinline__ float bf_hi(unsigned w) { return __uint_as_float(w & 0xffff0000u); }
__device__ __forceinline__ float wave_sum(float v) {
#pragma unroll
    for (int o = 1; o < 64; o <<= 1) v += __shfl_xor(v, o);
    return v;
}
__device__ __forceinline__ s16x4 tr_read(const LAS unsigned char* p) {
    typedef short v4i16_t __attribute__((ext_vector_type(4)));
    return __builtin_bit_cast(s16x4, __builtin_amdgcn_ds_read_tr16_b64_v4i16((LAS v4i16_t*)p));
}
#define MFMA16(a, b, c) __builtin_amdgcn_mfma_f32_16x16x32_bf16((a), (b), (c), 0, 0, 0)

struct Args {
    const float* x; const float* norm1_g; const float* w_in; const float* ln_g; const float* ln_b; const float* w_sp; const float* b_sp;
    const float* w_out; const float* norm2_g; const float* w_up; const float* w_down; const float* final_g;
    float* out; unsigned char* ws;
};

__device__ __forceinline__ void p0_transpose_item(const float* W, int K, int N, bf16* WT, int item, bool inproj, const float* gk, LAS float* scr, int lane) {
    const int nblk = N / 64, kb = item / nblk, nb = item % nblk, k0 = 64 * kb, n0 = 64 * nb;
    int sc = n0 + lane, cl = lane;
    if (inproj && n0 < 3072) {
        const int sec = n0 >> 10;
        if (sec == 1) sc = n0 + 1024 + lane;
        else { const int hb = (sec == 0 ? 1024 : 0) + (n0 & 1023 & ~127); sc = hb + ((n0 & 127) >> 1) + (lane & 31) + 64 * (lane >> 5); cl = 2 * (lane & 31) + (lane >> 5); }
    }
    const GAS1 float* src = (const GAS1 float*)(W + (size_t)k0 * N + sc);
    float tv[64];
#pragma unroll
    for (int kk = 0; kk < 64; ++kk) tv[kk] = src[(size_t)kk * N];
#pragma unroll
    for (int kk = 0; kk < 64; ++kk) scr[kk * 65 + cl] = tv[kk];
    LDS_WAIT(); asm volatile("" ::: "memory");
    const int c = lane >> 3;
    f32x4 g0 = (f32x4){1.f, 1.f, 1.f, 1.f}, g1 = g0;
    if (gk) { g0 = *(const f32x4*)(gk + k0 + 8 * c); g1 = *(const f32x4*)(gk + k0 + 8 * c + 4); }
#pragma unroll
    for (int j = 0; j < 8; ++j) { const int n = (lane & 7) + 8 * j; const LAS float* s = scr + (8 * c) * 65 + n;
        v4u o; o.x = pk2(s[0 * 65] * g0.x, s[1 * 65] * g0.y); o.y = pk2(s[2 * 65] * g0.z, s[3 * 65] * g0.w); o.z = pk2(s[4 * 65] * g1.x, s[5 * 65] * g1.y); o.w = pk2(s[6 * 65] * g1.z, s[7 * 65] * g1.w);
        *(GAS1 v4u*)(WT + (size_t)(n0 + n) * K + k0 + 8 * c) = o; }
    LDS_WAIT(); asm volatile("" ::: "memory");
}
__device__ __forceinline__ void rope_entry(int pos, int j, float& co, float& si) {
    double f = 1.0; double rr = 0.8659643233600653; int e = j;
    for (int b = 0; b < 6; ++b) { if (e & 1) f *= rr; rr *= rr; e >>= 1; }
    const double x = (double)pos * f;
    const double kq = __builtin_rint(x * 0.6366197723675814);
    double r = __builtin_fma(-kq, 1.5707963267948966, x); r = __builtin_fma(-kq, 6.123233995736766e-17, r);
    const double r2 = r * r;
    double s = -1.0 / 1307674368000.0; s = s * r2 + 1.0 / 6227020800.0; s = s * r2 - 1.0 / 39916800.0; s = s * r2 + 1.0 / 362880.0; s = s * r2 - 1.0 / 5040.0; s = s * r2 + 1.0 / 120.0; s = s * r2 - 1.0 / 6.0; s = s * r2 * r + r;
    double c = 1.0 / 20922789888000.0; c = c * r2 - 1.0 / 87178291200.0; c = c * r2 + 1.0 / 479001600.0; c = c * r2 - 1.0 / 3628800.0; c = c * r2 + 1.0 / 40320.0; c = c * r2 - 1.0 / 720.0; c = c * r2 + 1.0 / 24.0; c = c * r2 - 0.5; c = c * r2 + 1.0;
    const int q = ((int)kq) & 3;
    const double cc = (q == 0) ? c : (q == 1) ? -s : (q == 2) ? -c : s;
    const double ss = (q == 0) ? s : (q == 1) ? c : (q == 2) ? -s : -c;
    co = (float)cc; si = (float)ss;
}
__device__ __forceinline__ void rms_rows(const float* X, const float* g, bf16* H, float* OF, int gw, int NGW, int lane) {
    for (int m = gw; m < M; m += NGW) {
        const f32x4* xr = (const f32x4*)(X + (size_t)m * DM) + lane;
        f32x4 v[8]; float ss = 0.f;
#pragma unroll
        for (int j = 0; j < 8; ++j) { v[j] = xr[64 * j]; ss += (v[j].x * v[j].x + v[j].y * v[j].y) + (v[j].z * v[j].z + v[j].w * v[j].w); }
        const float rs = rsqrtf(wave_sum(ss) * (1.0f / DM) + 1e-6f);
        const f32x4* gr = (const f32x4*)g + lane;
        if (H) { v2u* o = (v2u*)(H + (size_t)m * DM) + lane;
#pragma unroll
            for (int j = 0; j < 8; ++j) { const f32x4 gg = gr[64 * j]; v2u w; w.x = pk2(v[j].x * rs * gg.x, v[j].y * rs * gg.y); w.y = pk2(v[j].z * rs * gg.z, v[j].w * rs * gg.w); o[64 * j] = w; }
        } else { f32x4* o = (f32x4*)(OF + (size_t)m * DM) + lane;
#pragma unroll
            for (int j = 0; j < 8; ++j) { const f32x4 gg = gr[64 * j]; o[64 * j] = v[j] * rs * gg; }
        }
    }
}

__device__ __forceinline__ void cast_rows(const float* X, bf16* H, float* ss, int gw, int NGW, int lane) {
    for (int m = gw; m < M; m += 2 * NGW) {
        const int m1 = m + NGW;
        const f32x4* xr0 = (const f32x4*)(X + (size_t)m * DM) + lane; const f32x4* xr1 = (const f32x4*)(X + (size_t)m1 * DM) + lane;
        f32x4 v0[8], v1[8];
#pragma unroll
        for (int j = 0; j < 8; ++j) { v0[j] = xr0[64 * j]; v1[j] = xr1[64 * j]; }
        v2u* o0 = (v2u*)(H + (size_t)m * DM) + lane; v2u* o1 = (v2u*)(H + (size_t)m1 * DM) + lane;
        float s0 = 0.f, s1 = 0.f;
#pragma unroll
        for (int j = 0; j < 8; ++j) { const f32x4 a = v0[j], b = v1[j];
            s0 += (a.x * a.x + a.y * a.y) + (a.z * a.z + a.w * a.w); s1 += (b.x * b.x + b.y * b.y) + (b.z * b.z + b.w * b.w);
            v2u w; w.x = pk2(a.x, a.y); w.y = pk2(a.z, a.w); o0[64 * j] = w; w.x = pk2(b.x, b.y); w.y = pk2(b.z, b.w); o1[64 * j] = w; }
        s0 = wave_sum(s0); s1 = wave_sum(s1);
        if (lane < 32) { ss[(size_t)lane * M + m] = lane == 0 ? s0 : 0.f; ss[(size_t)lane * M + m1] = lane == 0 ? s1 : 0.f; }
    }
}

__device__ __forceinline__ void final_rows(const bf16* XB, const float* ss, const float* g, float* OF, int gw, int NGW, int lane) {
    for (int m = gw; m < M; m += NGW) {
        const v4u* xr = (const v4u*)(XB + (size_t)m * DM) + lane; f32x4* o = (f32x4*)(OF + (size_t)m * DM); const f32x4* gr = (const f32x4*)g;
        const float rs = rsqrtf(ss[m] * (1.0f / DM) + 1e-6f);
#pragma unroll
        for (int j = 0; j < 4; ++j) { const v4u w = xr[64 * j]; const int c = 2 * (lane + 64 * j); const f32x4 g0 = gr[c], g1 = gr[c + 1];
            o[c] = (f32x4){bf_lo(w.x) * rs * g0.x, bf_hi(w.x) * rs * g0.y, bf_lo(w.y) * rs * g0.z, bf_hi(w.y) * rs * g0.w};
            o[c + 1] = (f32x4){bf_lo(w.z) * rs * g1.x, bf_hi(w.z) * rs * g1.y, bf_lo(w.w) * rs * g1.z, bf_hi(w.w) * rs * g1.w}; }
    }
}

__device__ __forceinline__ void final_tiles(LAS unsigned char* lds, const bf16* XB, const float* ss, const float* g, float* OF, int G, int bx, int tid) {
    pg8::StaticOrder S; S.init(M, DM, G, bx, WGM_DN); pg8::Unit u;
    const pg8::RsTable T = pg8::rs_prepass(lds + 131072, ss, S, tid);
    for (int i = 0; S.next(i, u); ++i) {
        const int k = u.pm == T.pm[0] ? 0 : (u.pm == T.pm[1] ? 1 : (u.pm == T.pm[2] ? 2 : 3));
#pragma unroll 4
        for (int q = 0; q < 16; ++q) {
            const int c = tid + 512 * q, lr = c >> 5, row = u.pm * 256 + lr, col = u.pn * 256 + (c & 31) * 8;
            const v4u w = *(const v4u*)(XB + (size_t)row * DM + col);
            const float rs = T.tab[k * 256 + lr];
            const f32x4 g0 = *(const f32x4*)(g + col), g1 = *(const f32x4*)(g + col + 4);
            f32x4* o = (f32x4*)(OF + (size_t)row * DM + col);
            o[0] = (f32x4){bf_lo(w.x) * rs * g0.x, bf_hi(w.x) * rs * g0.y, bf_lo(w.y) * rs * g0.z, bf_hi(w.y) * rs * g0.w};
            o[1] = (f32x4){bf_lo(w.z) * rs * g1.x, bf_hi(w.z) * rs * g1.y, bf_lo(w.w) * rs * g1.z, bf_hi(w.w) * rs * g1.w};
        }
    }
}

constexpr int KV_STRIDE = 288;
constexpr int LDS_V_OFF = 256 * KV_STRIDE;
struct AttnPre { v4u k[8], v[8]; bf16x8 q[4]; };
struct AttnUid { int bh, br, d, dl, r, n; };
__device__ __forceinline__ AttnUid attn_decode(int uid) {
    AttnUid u; u.bh = uid / 96; const int rem = uid % 96; u.br = rem >> 5; const int blk = rem & 31;
    u.dl = 2 * u.br; u.d = 1 << u.dl; const int nbl = 5 - u.dl; u.r = blk >> nbl; u.n = blk & ((1 << nbl) - 1); return u;
}
__device__ __forceinline__ void attn_load(AttnPre& P, const bf16* Z, const AttnUid& u, int tid, int wave, int lane) {
    const int b = u.bh >> 3, h = u.bh & 7;
    const bf16* Zb = Z + (size_t)b * SEQ * INW;
#pragma unroll
    for (int i = 0; i < 8; ++i) {
        const int c = tid + 512 * i, j = c >> 4, ch = c & 15;
        const int I = (u.n - 1) * 128 + j;
        if (I >= 0) { const bf16* p = Zb + (size_t)(I * u.d + u.r) * INW + h * HD + ch * 8; P.k[i] = *(const v4u*)p; P.v[i] = *(const v4u*)(p + 1024); }
        else { P.k[i] = (v4u){0u, 0u, 0u, 0u}; P.v[i] = P.k[i]; }
    }
    const int fr = lane & 15, fq = lane >> 4;
    const int qsub = u.n * 128 + 16 * wave + fr;
    const bf16* qp = Zb + (size_t)(qsub * u.d + u.r) * INW + 2048 + h * HD + 8 * fq;
#pragma unroll
    for (int ks = 0; ks < 4; ++ks) P.q[ks] = *(const bf16x8*)(qp + 32 * ks);
}
__device__ __forceinline__ void attn_stage(LAS unsigned char* lds, const AttnPre& P, int tid) {
#pragma unroll
    for (int i = 0; i < 8; ++i) {
        const int c = tid + 512 * i, j = c >> 4, ch = c & 15;
        *(LAS v4u*)(lds + j * KV_STRIDE + ch * 16) = P.k[i];
        *(LAS v4u*)(lds + LDS_V_OFF + j * KV_STRIDE + ch * 16) = P.v[i];
    }
}
__device__ __forceinline__ void attn_compute(LAS unsigned char* lds, const bf16x8 (&qf)[4], const AttnUid& u, bf16* ON, float* LSE, int wave, int lane) {
    const int fr = lane & 15, fq = lane >> 4;
    const int qi = 16 * wave + fr;
    const int qsub = u.n * 128 + qi;
    f32x4 S[10];
    const LAS unsigned char* kb = lds + (16 * wave + fr) * KV_STRIDE + 16 * fq;
    bf16x8 kf[3][4];
#define ATT_LOADK(buf, T) do { _Pragma("unroll") for (int ks_ = 0; ks_ < 4; ++ks_) kf[buf][ks_] = *(const LAS bf16x8*)(kb + (T) * 16 * KV_STRIDE + 64 * ks_); } while (0)
    ATT_LOADK(0, 0); ATT_LOADK(1, 1);
#pragma unroll
    for (int T = 0; T < 9; ++T) {
        if (T + 2 < 9) ATT_LOADK((T + 2) % 3, T + 2);
        __builtin_amdgcn_sched_barrier(0);
        S[T] = (f32x4){0.f, 0.f, 0.f, 0.f};
#pragma unroll
        for (int ks = 0; ks < 4; ++ks) S[T] = MFMA16(kf[T % 3][ks], qf[ks], S[T]);
        __builtin_amdgcn_sched_barrier(0);
    }
#undef ATT_LOADK
    S[9] = (f32x4){0.f, 0.f, 0.f, 0.f};
    const float NEG = -1.0e30f;
#pragma unroll
    for (int i = 0; i < 4; ++i) { if (4 * fq + i < fr) S[0][i] = NEG; if (4 * fq + i > fr) S[8][i] = NEG; }
    if (u.n == 0) {
#pragma unroll
        for (int T = 0; T < 9; ++T)
#pragma unroll
            for (int i = 0; i < 4; ++i) if (16 * wave + 16 * T + 4 * fq + i < 128) S[T][i] = NEG;
    }
    float mx = NEG;
#pragma unroll
    for (int T = 0; T < 9; ++T) mx = fmaxf(mx, fmaxf(fmaxf(S[T][0], S[T][1]), fmaxf(S[T][2], S[T][3])));
    mx = pg8::max_16_32(mx);
    float l = 0.f;
#pragma unroll
    for (int T = 0; T < 9; ++T)
#pragma unroll
        for (int i = 0; i < 4; ++i) { const float p = __builtin_amdgcn_exp2f(S[T][i] - mx); S[T][i] = p; l += p; }
    l = pg8::sum_16_32(l);
    const float inv = 1.0f / l;
    bf16x8 pf[5];
#pragma unroll
    for (int s = 0; s < 5; ++s) { v4u w; w.x = pk2(S[2 * s][0], S[2 * s][1]); w.y = pk2(S[2 * s][2], S[2 * s][3]); w.z = pk2(S[2 * s + 1][0], S[2 * s + 1][1]); w.w = pk2(S[2 * s + 1][2], S[2 * s + 1][3]); pf[s] = __builtin_bit_cast(bf16x8, w); }
    const int i16 = lane & 15;
    const LAS unsigned char* vb = lds + LDS_V_OFF + (16 * wave + 4 * fq + (i16 >> 2)) * KV_STRIDE + 8 * (i16 & 3);
    const int pp = u.r * (SEQ >> u.dl) + qsub;
    bf16* op = ON + ((size_t)(u.br * 32 + u.bh) * SEQ + pp) * HD + 4 * fq;
    v2u wprev = (v2u){0u, 0u};
    bf16x8 vf[2][5];
#define ATT_LOADV(buf, dt_) do { _Pragma("unroll") for (int s_ = 0; s_ < 5; ++s_) { const s16x4 lo_ = tr_read(vb + (32 * s_) * KV_STRIDE + 32 * (dt_)); \
        const s16x4 hi_ = (s_ < 4) ? tr_read(vb + (32 * s_ + 16) * KV_STRIDE + 32 * (dt_)) : lo_; vf[buf][s_] = __builtin_shufflevector(lo_, hi_, 0, 1, 2, 3, 4, 5, 6, 7); } } while (0)
    ATT_LOADV(0, 0);
#pragma unroll
    for (int dt = 0; dt < 8; ++dt) {
        if (dt + 1 < 8) ATT_LOADV((dt + 1) & 1, dt + 1);
        __builtin_amdgcn_sched_barrier(0);
        f32x4 O = (f32x4){0.f, 0.f, 0.f, 0.f};
#pragma unroll
        for (int s = 0; s < 5; ++s) O = MFMA16(vf[dt & 1][s], pf[s], O);
        v2u w; w.x = pk2(O[0] * inv, O[1] * inv); w.y = pk2(O[2] * inv, O[3] * inv);
        if ((dt & 1) == 0) wprev = w;
        else {
            const auto rx = __builtin_amdgcn_permlane16_swap(wprev.x, w.x, false, false); const auto ry = __builtin_amdgcn_permlane16_swap(wprev.y, w.y, false, false);
            const v4u q = (v4u){rx[0], ry[0], rx[1], ry[1]};
            *(v4u*)(op - 4 * fq + 4 * (fq & ~1) + 16 * (dt - 1 + (fq & 1))) = q;
        }
        __builtin_amdgcn_sched_barrier(0);
    }
#undef ATT_LOADV
    if (fq == 0) LSE[(size_t)(u.br * 32 + u.bh) * SEQ + pp] = mx + __builtin_amdgcn_logf(l);
}

struct GmlpPre { v4u v[4]; v4u u[4]; };
__device__ __forceinline__ void gmlp_load(GmlpPre& P, const bf16* Z, int uid, int tid, int wave, int lane) {
    const int g = uid & 7, c = (uid >> 3) & 31, b = uid >> 8;
    const size_t row0 = (size_t)b * SEQ + 128 * c;
    const v4u* vp = (const v4u*)(Z + (row0 + (tid >> 2)) * INW + 4096 + g * HD + 32 * (tid & 3));
#pragma unroll
    for (int k = 0; k < 4; ++k) P.v[k] = vp[k];
    const int fq_ = lane >> 4;
    const bf16* up = Z + (row0 + 16 * wave + (lane & 15)) * INW + 3072 + g * HD + 4 * (fq_ & ~1) + 16 * (fq_ & 1);
#pragma unroll
    for (int p = 0; p < 4; ++p) P.u[p] = *(const v4u*)(up + 32 * p);
}
__device__ __forceinline__ void gmlp_phase(LAS unsigned char* lds, bf16* Z, const bf16* WSP, const float* bsp, const float* lng, const float* lnb, int bx, int G, int tid, int wave, int lane) {
    const int fr = lane & 15, fq = lane >> 4, i16 = lane & 15;
    const int g = bx & 7, t = 16 * wave + fr, d0 = 32 * (tid & 3);
    bf16x8 wf[4];
    { const bf16* wp = WSP + ((size_t)g * 128 + t) * 128 + 4 * fq;
#pragma unroll
      for (int ks = 0; ks < 4; ++ks) { const v2u wlo = *(const v2u*)(wp + 32 * ks), whi = *(const v2u*)(wp + 32 * ks + 16); wf[ks] = __builtin_bit_cast(bf16x8, (v4u){wlo.x, wlo.y, whi.x, whi.y}); } }
    const float bs = bsp[g * 128 + t];
    f32x4 lg[8], lb[8];
#pragma unroll
    for (int k = 0; k < 8; ++k) { lg[k] = *(const f32x4*)(lng + g * HD + d0 + 4 * k); lb[k] = *(const f32x4*)(lnb + g * HD + d0 + 4 * k); }
    const LAS unsigned char* vb = lds + (4 * fq + (i16 >> 2)) * KV_STRIDE + 8 * (i16 & 3);
    const int nks = (wave >> 1) + 1;
    GmlpPre P;
    int uid = bx;
    if (uid < 1024) gmlp_load(P, Z, uid, tid, wave, lane);
#pragma nounroll
    for (; uid < 1024; uid += G) {
        {
            float x[32]; float sum = 0.f;
#pragma unroll
            for (int k = 0; k < 4; ++k) { const v4u w = P.v[k];
                x[8 * k + 0] = bf_lo(w.x); x[8 * k + 1] = bf_hi(w.x); x[8 * k + 2] = bf_lo(w.y); x[8 * k + 3] = bf_hi(w.y);
                x[8 * k + 4] = bf_lo(w.z); x[8 * k + 5] = bf_hi(w.z); x[8 * k + 6] = bf_lo(w.w); x[8 * k + 7] = bf_hi(w.w); }
#pragma unroll
            for (int e = 0; e < 32; ++e) sum += x[e];
            sum += pg8::lane_xor1(sum); sum += pg8::lane_xor2(sum);
            const float mu = sum * (1.0f / 128.0f); float var = 0.f;
#pragma unroll
            for (int e = 0; e < 32; ++e) { x[e] -= mu; var += x[e] * x[e]; }
            var += pg8::lane_xor1(var); var += pg8::lane_xor2(var);
            const float rstd = rsqrtf(var * (1.0f / 128.0f) + 1e-5f);
#pragma unroll
            for (int k = 0; k < 4; ++k) { const f32x4 g0 = lg[2 * k], g1 = lg[2 * k + 1], b0 = lb[2 * k], b1 = lb[2 * k + 1];
                v4u w; w.x = pk2(x[8 * k + 0] * rstd * g0.x + b0.x, x[8 * k + 1] * rstd * g0.y + b0.y); w.y = pk2(x[8 * k + 2] * rstd * g0.z + b0.z, x[8 * k + 3] * rstd * g0.w + b0.w);
                w.z = pk2(x[8 * k + 4] * rstd * g1.x + b1.x, x[8 * k + 5] * rstd * g1.y + b1.y); w.w = pk2(x[8 * k + 6] * rstd * g1.z + b1.z, x[8 * k + 7] * rstd * g1.w + b1.w);
                *(LAS v4u*)(lds + (tid >> 2) * KV_STRIDE + d0 * 2 + 16 * k) = w; }
        }
        v2u uc[8];
#pragma unroll
        for (int p = 0; p < 4; ++p) {
            const auto rx = __builtin_amdgcn_permlane16_swap(P.u[p].x, P.u[p].z, false, false); const auto ry = __builtin_amdgcn_permlane16_swap(P.u[p].y, P.u[p].w, false, false);
            uc[2 * p] = (v2u){rx[0], ry[0]}; uc[2 * p + 1] = (v2u){rx[1], ry[1]}; }
        const int c = (uid >> 3) & 31, b = uid >> 8;
        bf16* op = Z + ((size_t)b * SEQ + 128 * c + t) * INW + 3072 + g * HD + 4 * fq;
        __syncthreads();
        if (uid + G < 1024) gmlp_load(P, Z, uid + G, tid, wave, lane);
        f32x4 acc[8];
#pragma unroll
        for (int dt = 0; dt < 8; ++dt) acc[dt] = (f32x4){0.f, 0.f, 0.f, 0.f};
#pragma unroll
        for (int ks = 0; ks < 4; ++ks) {
            if (ks < nks) {
#pragma unroll
                for (int dt = 0; dt < 8; ++dt) {
                    const s16x4 lo = tr_read(vb + (32 * ks) * KV_STRIDE + 32 * dt);
                    const s16x4 hi = tr_read(vb + (32 * ks + 16) * KV_STRIDE + 32 * dt);
                    const bf16x8 vf = __builtin_shufflevector(lo, hi, 0, 1, 2, 3, 4, 5, 6, 7);
                    acc[dt] = MFMA16(vf, wf[ks], acc[dt]);
                }
            }
        }
        v2u wprev = (v2u){0u, 0u};
#pragma unroll
        for (int dt = 0; dt < 8; ++dt) {
            const v2u uu = uc[dt];
            v2u w; w.x = pk2(bf_lo(uu.x) * (acc[dt][0] + bs), bf_hi(uu.x) * (acc[dt][1] + bs)); w.y = pk2(bf_lo(uu.y) * (acc[dt][2] + bs), bf_hi(uu.y) * (acc[dt][3] + bs));
            if ((dt & 1) == 0) wprev = w;
            else { const auto rx = __builtin_amdgcn_permlane16_swap(wprev.x, w.x, false, false); const auto ry = __builtin_amdgcn_permlane16_swap(wprev.y, w.y, false, false);
                   *(v4u*)(op - 4 * fq + 4 * (fq & ~1) + 16 * (dt - 1 + (fq & 1))) = (v4u){rx[0], ry[0], rx[1], ry[1]}; }
        }
        __syncthreads();
    }
}

__device__ __forceinline__ void combine_rows(const bf16* ON, const float* LSE, bf16* Z, int gw, int NGW, int lane) {
    const int l16 = lane & 15, hq = lane >> 4;
    for (int m = gw; m < M; m += NGW) {
        const int b = m >> 12, t = m & 4095;
#pragma unroll
        for (int it = 0; it < 2; ++it) {
            const int h = 4 * it + hq, bh = b * 8 + h;
            float ls[3]; v4u ov[3];
#pragma unroll
            for (int br = 0; br < 3; ++br) { const int dl = 2 * br; const int pp = (t & ((1 << dl) - 1)) * (SEQ >> dl) + (t >> dl);
                const size_t idx = (size_t)(br * 32 + bh) * SEQ + pp; ls[br] = LSE[idx]; ov[br] = *(const v4u*)(ON + idx * HD + 8 * l16); }
            const float mx = fmaxf(ls[0], fmaxf(ls[1], ls[2]));
            const float w0 = __builtin_amdgcn_exp2f(ls[0] - mx), w1 = __builtin_amdgcn_exp2f(ls[1] - mx), w2 = __builtin_amdgcn_exp2f(ls[2] - mx);
            const float inv = 1.0f / (w0 + w1 + w2);
            const float a0 = w0 * inv, a1 = w1 * inv, a2 = w2 * inv;
            v4u o;
            o.x = pk2(a0 * bf_lo(ov[0].x) + a1 * bf_lo(ov[1].x) + a2 * bf_lo(ov[2].x), a0 * bf_hi(ov[0].x) + a1 * bf_hi(ov[1].x) + a2 * bf_hi(ov[2].x));
            o.y = pk2(a0 * bf_lo(ov[0].y) + a1 * bf_lo(ov[1].y) + a2 * bf_lo(ov[2].y), a0 * bf_hi(ov[0].y) + a1 * bf_hi(ov[1].y) + a2 * bf_hi(ov[2].y));
            o.z = pk2(a0 * bf_lo(ov[0].z) + a1 * bf_lo(ov[1].z) + a2 * bf_lo(ov[2].z), a0 * bf_hi(ov[0].z) + a1 * bf_hi(ov[1].z) + a2 * bf_hi(ov[2].z));
            o.w = pk2(a0 * bf_lo(ov[0].w) + a1 * bf_lo(ov[1].w) + a2 * bf_lo(ov[2].w), a0 * bf_hi(ov[0].w) + a1 * bf_hi(ov[1].w) + a2 * bf_hi(ov[2].w));
            *(v4u*)(Z + (size_t)m * INW + 2048 + h * HD + 8 * l16) = o;
        }
    }
}

typedef __attribute__((address_space(1))) unsigned gu32;
#define RLX_AGENT __ATOMIC_RELAXED, __HIP_MEMORY_SCOPE_AGENT
#define XB_TMO      128
#define XB_XCNT(j)  (256  + 64 * (j))
#define XB_XSUB(j)  (1280 + 64 * (j))
#define XB_XGEN(j)  (2304 + 64 * (j))
#define XB_TOP      3328
#define XB_TOPGEN   3392
#define XCD_BAR_WORDS 3456
#define XB_SPIN_CAP (1u << 18)

__device__ __forceinline__ unsigned xb_ld(unsigned* p)              { return __hip_atomic_load((GAS1 unsigned*)p, __ATOMIC_RELAXED, __HIP_MEMORY_SCOPE_AGENT); }
__device__ __forceinline__ unsigned xb_add(unsigned* p, unsigned v) { return __hip_atomic_fetch_add((GAS1 unsigned*)p, v, __ATOMIC_RELAXED, __HIP_MEMORY_SCOPE_AGENT); }
__device__ __forceinline__ unsigned xb_xcc_id() { return (unsigned)__builtin_amdgcn_s_getreg((3 << 11) | 20) & 0xFu; }
#define XB_SPIN(cond, bar) do { unsigned _sp = 0; while (cond) { __builtin_amdgcn_s_sleep(1); \
    if ((++_sp & 255u) == 0u) { if (xb_ld(&(bar)[XB_TMO])) break; if (_sp > XB_SPIN_CAP) { atomicAdd(&(bar)[XB_TMO], 1u); break; } } } } while (0)

struct XcdBarrier {
    unsigned* bar; unsigned x;
    volatile LAS unsigned* st;
};

__device__ __forceinline__ XcdBarrier xcd_barrier_post(unsigned* bar, volatile LAS unsigned* st) {
    XcdBarrier b; b.bar = bar; b.x = xb_xcc_id(); b.st = st;
    if (threadIdx.x == 0) (void)xb_add(&bar[XB_XCNT(b.x)], 1u);
    return b;
}
__device__ __forceinline__ void xcd_barrier_complete(unsigned* bar, unsigned x, unsigned& nloc, unsigned& nx) {
    const unsigned G = gridDim.x * gridDim.y * gridDim.z;
    unsigned sum, cnt, mine, sp = 0u;
    for (;;) {
        sum = 0u; cnt = 0u; mine = 0u;
#pragma unroll
        for (unsigned j = 0; j < 16; ++j) { const unsigned c = xb_ld(&bar[XB_XCNT(j)]); sum += c; cnt += (c > 0u) ? 1u : 0u; mine = (j == x) ? c : mine; }
        if (sum == G) break;
        __builtin_amdgcn_s_sleep(1);
        if ((++sp & 255u) == 0u) { if (xb_ld(&bar[XB_TMO])) break; if (sp > XB_SPIN_CAP) { atomicAdd(&bar[XB_TMO], 1u); break; } }
    }
    nloc = mine > 0u ? mine : 1u; nx = cnt > 0u ? cnt : 1u;
}

__device__ __forceinline__ void xcd_barrier(const XcdBarrier& b, const int wave) {
    const bool leader = wave == 0 && pg8::fresh_lane() == 0;
    asm volatile("s_waitcnt vmcnt(0)" ::: "memory");
    __syncthreads();
    if (leader) {
        const unsigned bxx = xb_xcc_id();
        unsigned* bar = b.bar; asm volatile("" : "+s"(bar));
        __builtin_amdgcn_s_waitcnt(0);
        const unsigned nloc = b.st[0], nx = b.st[1];
        const unsigned old = xb_add(&bar[XB_XSUB(bxx)], 1u);
        const unsigned gen = old / nloc;
        if (old + 1u == (gen + 1u) * nloc) {
            __builtin_amdgcn_fence(__ATOMIC_RELEASE, "agent");
            asm volatile("s_waitcnt vmcnt(0)" ::: "memory");
            const unsigned og = xb_add(&bar[XB_TOP], 1u);
            const unsigned tg = og / nx;
            if (og + 1u == (tg + 1u) * nx) xb_add(&bar[XB_TOPGEN], 1u);
            else XB_SPIN(xb_ld(&bar[XB_TOPGEN]) == tg, bar);
            __builtin_amdgcn_fence(__ATOMIC_ACQUIRE, "agent");
            xb_add(&bar[XB_XGEN(bxx)], 1u);
            asm volatile("s_waitcnt vmcnt(0)" ::: "memory");
        } else {
            XB_SPIN(xb_ld(&bar[XB_XGEN(bxx)]) == gen, bar);
            __builtin_amdgcn_fence(__ATOMIC_ACQUIRE, "agent");
            asm volatile("s_waitcnt vmcnt(0)" ::: "memory");
        }
    }
    __syncthreads();
}

__global__ void __launch_bounds__(NWAVES * 64, 2) hybrid_fwd(Args a) {
    extern __shared__ __attribute__((aligned(16))) unsigned char lds_raw[];
    cg::grid_group grid = cg::this_grid();
    LAS unsigned char* lds = (LAS unsigned char*)lds_raw;
    const int G = gridDim.x, bx = blockIdx.x, NGW = G * NWAVES;
    const int wave_k = __builtin_amdgcn_readfirstlane((int)threadIdx.x >> 6);
#define FRESH_IDS() int wave = wave_k; asm volatile("" : "+s"(wave)); const int lane = pg8::fresh_lane(); const int tid = wave * 64 + lane; const int gw = bx * NWAVES + wave; (void)gw; (void)tid
    unsigned char* ws = a.ws;
#define WSPTR(T, off) ((T*)(GAS1 T*)({ unsigned char* p_ = a.ws; asm volatile("" : "+s"(p_)); (GAS1 unsigned char*)p_ + (off); }))
#define Wi WSPTR(bf16, WS_WIN)
#define Wo WSPTR(bf16, WS_WOUT)
#define Wu WSPTR(bf16, WS_WUP)
#define Wd WSPTR(bf16, WS_WDN)
#define ACT WSPTR(bf16, WS_ACT)
#define Z WSPTR(bf16, WS_Z)
#define ON WSPTR(bf16, WS_ON)
#define U WSPTR(bf16, WS_U)
#define SS WSPTR(float, WS_SS)
#define LSE WSPTR(float, WS_LSE)
#define ROPE WSPTR(float, WS_ROPE)
#define WSP WSPTR(bf16, WS_WSP)

    unsigned* barw = (unsigned*)(ws + WS_BAR);
    if (bx == 0) for (int i = threadIdx.x; i < XCD_BAR_WORDS; i += NWAVES * 64) barw[i] = 0u;
    volatile LAS unsigned* bst = (volatile LAS unsigned*)(lds + LDS_MAIN);
    {
        FRESH_IDS();
        LAS float* scr = (LAS float*)(lds + wave * 16640);
        constexpr int I_IN = (DM / 64) * (INW / 64), I_OUT = (DM / 64) * (DM / 64), I_UP = (DM / 64) * (DFF / 64), I_DN = (DFF / 64) * (DM / 64);
        constexpr int PER_L = I_IN + I_OUT + I_UP + I_DN;
        for (int it = gw; it < DEPTH * PER_L; it += NGW) {
            const int l = it / PER_L; int r = it % PER_L;
            if (r < I_IN) { p0_transpose_item(a.w_in + (size_t)l * DM * INW, DM, INW, Wi + (size_t)l * INW * DM, r, true, a.norm1_g + l * DM, scr, lane); continue; } r -= I_IN;
            if (r < I_OUT) { p0_transpose_item(a.w_out + (size_t)l * DM * DM, DM, DM, Wo + (size_t)l * DM * DM, r, false, nullptr, scr, lane); continue; } r -= I_OUT;
            if (r < I_UP) { p0_transpose_item(a.w_up + (size_t)l * DM * DFF, DM, DFF, Wu + (size_t)l * DFF * DM, r, false, a.norm2_g + l * DM, scr, lane); continue; } r -= I_UP;
            p0_transpose_item(a.w_down + (size_t)l * DFF * DM, DFF, DM, Wd + (size_t)l * DM * DFF, r, false, nullptr, scr, lane);
        }
        for (int e = bx * 512 + tid; e < SEQ * 64; e += G * 512) { float co, si; rope_entry(e >> 6, e & 63, co, si); ROPE[2 * e] = co; ROPE[2 * e + 1] = si; }
        for (int e = bx * 512 + tid; e < DEPTH * 8 * 128 * 128; e += G * 512) { const int s = e & 127, t = (e >> 7) & 127; const float w = a.w_sp[e]; WSP[e] = (bf16)(pk2(s <= t ? w : 0.f, 0.f) & 0xffffu); }
        cast_rows(a.x, ACT, SS, gw, NGW, lane);
    }
    grid.sync();
    const XcdBarrier bar = xcd_barrier_post(barw, bst);
    if (wave_k == 0 && pg8::fresh_lane() == 0) { unsigned nloc, nx; xcd_barrier_complete(barw, bar.x, nloc, nx); bst[0] = nloc; bst[1] = nx; }
    __syncthreads();

#pragma nounroll
    for (int l = 0; l < DEPTH; ++l) {
        { pg8::Gemm g{ACT, Wi + (size_t)l * INW * DM, M, INW, DM, DM}; pg8::StaticOrder S; S.init(M, INW, G, bx, WGM_IN);
          FRESH_IDS(); const pg8::RsTable rst = pg8::rs_prepass(lds + 131072, SS, S, tid);
          pg8::EpiInProj E{Z, ROPE, rst};
          pg8::gemm_phase<pg8::EpiInProj, pg8::StaticOrder, true, true>(lds, g, S, E, wave_k); }
        xcd_barrier(bar, wave_k);
        {
            FRESH_IDS();
            const int vx = bx & 7, vr = bx >> 3;
            AttnPre P; AttnUid cu = attn_decode((4 * vx) * 96 + vr);
            attn_load(P, Z, cu, tid, wave, lane);
#pragma nounroll
            for (int idx = 0; idx < 12; ++idx) {
                attn_stage(lds, P, tid);
                bf16x8 qf[4] = {P.q[0], P.q[1], P.q[2], P.q[3]};
                __syncthreads();
                const AttnUid u = cu;
                if (idx + 1 < 12) { const int nx = idx + 1; cu = attn_decode((4 * vx + nx / 3) * 96 + (nx % 3) * 32 + vr); attn_load(P, Z, cu, tid, wave, lane); }
                attn_compute(lds, qf, u, ON, LSE, wave, lane);
                __syncthreads();
            }
        }
        { FRESH_IDS(); gmlp_phase(lds, Z, WSP + (size_t)l * 8 * 128 * 128, a.b_sp + l * 1024, a.ln_g + l * 1024, a.ln_b + l * 1024, bx, G, tid, wave, lane); }
        xcd_barrier(bar, wave_k);
        { FRESH_IDS(); combine_rows(ON, LSE, Z, gw, NGW, lane); }
        xcd_barrier(bar, wave_k);
        { pg8::Gemm g{Z + 2048, Wo + (size_t)l * DM * DM, M, DM, DM, INW}; pg8::StaticOrder S; S.init(M, DM, G, bx, WGM_OUT);
          pg8::EpiResid E{a.out, ACT, SS, 0};
          pg8::gemm_phase<pg8::EpiResid, pg8::StaticOrder, true, true>(lds, g, S, E, wave_k); }
        xcd_barrier(bar, wave_k);
        { pg8::Gemm g{ACT, Wu + (size_t)l * DFF * DM, M, DFF, DM, DM}; pg8::StaticOrder S; S.init(M, DFF, G, bx, WGM_UP);
          FRESH_IDS(); const pg8::RsTable rst = pg8::rs_prepass(lds + 131072, SS, S, tid);
          pg8::EpiRelu2 E{U, DFF, rst};
          pg8::gemm_phase<pg8::EpiRelu2, pg8::StaticOrder, true, true>(lds, g, S, E, wave_k); }
        xcd_barrier(bar, wave_k);
        { pg8::Gemm g{U, Wd + (size_t)l * DM * DFF, M, DM, DFF, DFF}; pg8::StaticOrder S; S.init(M, DM, G, bx, WGM_DN);
          pg8::EpiResid E{a.out, ACT, SS, 0};
          pg8::gemm_phase<pg8::EpiResid, pg8::StaticOrder, true, true>(lds, g, S, E, wave_k); }
        xcd_barrier(bar, wave_k);
        if (l + 1 == DEPTH) { FRESH_IDS(); final_tiles(lds, ACT, SS, a.final_g, a.out, G, bx, tid); }
    }
}

#undef Wi
#undef Wo
#undef Wu
#undef Wd
#undef ACT
#undef Z
#undef ON
#undef U
#undef SS
#undef LSE
#undef ROPE
#undef WSP
extern "C" void kernel_launch(void* const* d_in, const int* in_sizes, int n_in, void* d_out, int out_size, void* d_ws, size_t ws_size, hipStream_t stream) {
    static int grid = 0;
    if (grid == 0) {
        if (n_in != 12 || in_sizes[0] != M * DM || out_size != M * DM || ws_size < WS_END) { fprintf(stderr, "kernel_launch: unexpected shapes (n_in %d, ws %zu)\n", n_in, ws_size); grid = -1; return; }
        int dev = 0, cus = 0, per_cu = 0;
        hipGetDevice(&dev); hipDeviceGetAttribute(&cus, hipDeviceAttributeMultiprocessorCount, dev);
        if (hipFuncSetAttribute((const void*)hybrid_fwd, hipFuncAttributeMaxDynamicSharedMemorySize, LDS_BYTES) != hipSuccess) { fprintf(stderr, "kernel_launch: hipFuncSetAttribute failed\n"); grid = -1; return; }
        if (hipOccupancyMaxActiveBlocksPerMultiprocessor(&per_cu, (const void*)hybrid_fwd, NWAVES * 64, LDS_BYTES) != hipSuccess || per_cu < 1) { fprintf(stderr, "kernel_launch: occupancy query says %d\n", per_cu); per_cu = 1; }
        (void)hipGetLastError();
        grid = 256;
        if (cus != 256) fprintf(stderr, "kernel_launch: built for 256 CUs, device has %d\n", cus);
    }
    if (grid < 0) return;
    Args a{};
    a.x = (const float*)d_in[0]; a.norm1_g = (const float*)d_in[1]; a.w_in = (const float*)d_in[2]; a.ln_g = (const float*)d_in[3]; a.ln_b = (const float*)d_in[4];
    a.w_sp = (const float*)d_in[5]; a.b_sp = (const float*)d_in[6]; a.w_out = (const float*)d_in[7]; a.norm2_g = (const float*)d_in[8]; a.w_up = (const float*)d_in[9];
    a.w_down = (const float*)d_in[10]; a.final_g = (const float*)d_in[11]; a.out = (float*)d_out; a.ws = (unsigned char*)d_ws;
    void* args[] = {&a};
    hipError_t e = hipLaunchCooperativeKernel((const void*)hybrid_fwd, dim3(grid), dim3(NWAVES * 64), args, LDS_BYTES, stream);
    if (e != hipSuccess) fprintf(stderr, "cooperative launch failed: %s (grid %d)\n", hipGetErrorString(e), grid);
}
```

```cpp
#include <hip/hip_runtime.h>
#include <hip/hip_cooperative_groups.h>
#include <cstdio>
#include <cstdint>
namespace cg = cooperative_groups;
namespace pg8 {
#define PG8_LAS __attribute__((address_space(3)))
typedef unsigned short bf16_t;
typedef short bf16x8 __attribute__((ext_vector_type(8)));
typedef float f32x4 __attribute__((ext_vector_type(4)));
typedef unsigned u32x4 __attribute__((ext_vector_type(4)));


__device__ __forceinline__ int fresh_lane() { int l; asm volatile("v_mbcnt_lo_u32_b32 %0, -1, 0\n\tv_mbcnt_hi_u32_b32 %0, -1, %0" : "=v"(l)); return l; }
__device__ __forceinline__ float lane_xor1(float v) { return __shfl_xor(v, 1); }
__device__ __forceinline__ float lane_xor2(float v) { return __shfl_xor(v, 2); }
__device__ __forceinline__ float lane_xor16(float v) { return __builtin_bit_cast(float, __builtin_amdgcn_ds_swizzle(__builtin_bit_cast(int, v), 0x401F)); }
__device__ __forceinline__ float sum_16_32(float v) { v += __shfl_xor(v, 16); v += __shfl_xor(v, 32); return v; }
__device__ __forceinline__ float max_16_32(float v) { v = fmaxf(v, __shfl_xor(v, 16)); v = fmaxf(v, __shfl_xor(v, 32)); return v; }
constexpr int BM = 256, BK = 64, HALF = 128, HTB = HALF * BK * 2  , STAGE_BYTES = 8 * HTB, NXCD = 8, WGM = 4;

__host__ __device__ __forceinline__ int lds_byte(int r, int c) { const int st = (r >> 4) * 2 + (c >> 5), rr = r & 15, cc = c & 31, ob = rr * 64 + cc * 2; return st * 1024 + (ob ^ (((ob >> 9) & 1) << 5)); }
__host__ __device__ __forceinline__ void stage_rc(int b, int& R, int& C) { const int st = b / 1024, sb = b % 1024, swz = sb ^ (((sb >> 9) & 1) << 5); R = (st >> 1) * 16 + swz / 64; C = (st & 1) * 32 + (swz % 64) / 2; }
__host__ __device__ __forceinline__ int perm32(int rho) { const int n = rho >> 4, i = rho & 15; return 8 * (i >> 2) + 4 * n + (i & 3); }

struct Unit { int pm, pn; };
struct Gemm { const bf16_t* A; const bf16_t* Bt; int M, N, K, lda; };

struct StaticOrder {
    int nM, nN, nwg, G, c, wgm;
    __host__ __device__ void init(int M, int N, int G_, int c_, int wgm_ = WGM) { nM = M / BM; nN = N / BM; nwg = nM * nN; G = G_; c = c_; wgm = wgm_; }
    __host__ __device__ bool next(int i, Unit& u) const {
        const long L = (long)i * G + c; if (L >= nwg) return false;
        int wgid = (int)L; { const int q = nwg / NXCD, r = nwg % NXCD, xcd = wgid % NXCD, off = wgid / NXCD; wgid = (xcd < r ? xcd * (q + 1) : r * (q + 1) + (xcd - r) * q) + off; }
        const int nig = wgm * nN, gid = wgid / nig, fm = gid * wgm, gsz = (nM - fm) < wgm ? (nM - fm) : wgm;
        u.pm = fm + ((wgid % nig) % gsz); u.pn = (wgid % nig) / gsz; return true;
    }
    __device__ __forceinline__ void a_ready(const Unit&) const {}
    __device__ __forceinline__ void done(const Unit&) const {}
};

__device__ __forceinline__ unsigned cvt_pk_bf16(float lo, float hi) { unsigned r; asm volatile("v_cvt_pk_bf16_f32 %0, %1, %2" : "=v"(r) : "v"(lo), "v"(hi)); return r; }
typedef float f32x2 __attribute__((ext_vector_type(2)));
__device__ __forceinline__ f32x2 gelu_pk(f32x2 v) {
    const f32x2 av = __builtin_elementwise_abs(v), d = av * 0.2316418882f + 1.0f;
    f32x2 t; t.x = __builtin_amdgcn_rcpf(d.x); t.y = __builtin_amdgcn_rcpf(d.y);
    f32x2 q = t * 0.5307027145f + (-0.7265760135f); q = q * t + 0.7107068705f; q = q * t + (-0.142248368f); q = q * t + 0.127414796f; q = q * t;
    const f32x2 s = (v * v) * (-0.72134752044f);
    f32x2 e; e.x = __builtin_amdgcn_exp2f(s.x); e.y = __builtin_amdgcn_exp2f(s.y);
    const f32x2 m = v * (q * e), r = v - m;
    f32x2 o; o.x = v.x < 0.f ? m.x : r.x; o.y = v.y < 0.f ? m.y : r.y; return o;
}


__device__ __forceinline__ float gelu_tanh(float x) {
    const float y = x * (0.7978845608028654f + 0.7978845608028654f * 0.044715f * x * x);
    const float e = __builtin_amdgcn_exp2f(-2.0f * 1.4426950408889634f * y);
    return x * __builtin_amdgcn_rcpf(1.0f + e);
}


#define EPI_FENCE() asm volatile("" ::: "memory")
struct RsTable { int pm[4]; const PG8_LAS float* tab; };
template <class Sched>
__device__ __forceinline__ RsTable rs_prepass(PG8_LAS unsigned char* lds_spare, const float* ssp, const Sched& S, int tid) {
    RsTable T; T.pm[0] = T.pm[1] = T.pm[2] = T.pm[3] = -1; T.tab = (const PG8_LAS float*)(lds_spare + 4096);
    Unit u;
    for (int i = 0; S.next(i, u); ++i) { if (u.pm == T.pm[0] || u.pm == T.pm[1] || u.pm == T.pm[2] || u.pm == T.pm[3]) continue;
        if (T.pm[0] < 0) T.pm[0] = u.pm; else if (T.pm[1] < 0) T.pm[1] = u.pm; else if (T.pm[2] < 0) T.pm[2] = u.pm; else T.pm[3] = u.pm; }
    PG8_LAS float* part = (PG8_LAS float*)lds_spare;
    PG8_LAS float* tab = (PG8_LAS float*)(lds_spare + 4096);
    const int row = tid & 255, half = tid >> 8;
#pragma unroll
    for (int k = 0; k < 4; ++k) {
        if (T.pm[k] < 0) continue;
        const float* p = ssp + (size_t)(16 * half) * 16384 + T.pm[k] * 256 + row; float s = 0.f;
#pragma unroll
        for (int q = 0; q < 16; ++q) s += p[(size_t)q * 16384];
        part[half * 256 + row] = s;
        __syncthreads();
        if (half == 0) tab[k * 256 + row] = rsqrtf((part[row] + part[256 + row]) * (1.0f / 2048.0f) + 1e-6f);
        __syncthreads();
    }
    return T;
}
__device__ __forceinline__ void load_rs(float (&rs)[8], const RsTable& T, int pm, int lrow0) {
    const int k = pm == T.pm[0] ? 0 : (pm == T.pm[1] ? 1 : (pm == T.pm[2] ? 2 : 3));
#pragma unroll
    for (int i = 0; i < 8; ++i) rs[i] = T.tab[k * 256 + lrow0 + (i >> 2) * HALF + (i & 3) * 16];
}

struct EpiInProj {
    static constexpr bool PERM = true, AFTER_DRAIN = false;
    __device__ __forceinline__ void init(f32x4 (&acc)[2][2][4][2], const Unit&, int, int, int, int) const {
#pragma unroll
        for (int a = 0; a < 2; ++a)
#pragma unroll
            for (int b = 0; b < 2; ++b)
#pragma unroll
                for (int m = 0; m < 4; ++m)
#pragma unroll
                    for (int n = 0; n < 2; ++n) acc[a][b][m][n] = (f32x4){0.f, 0.f, 0.f, 0.f};
    }
    bf16_t* Z; const float* rope; RsTable rst;
    __device__ __forceinline__ void operator()(const f32x4 (&acc)[2][2][4][2], const Unit& u, int wr, int wc, int fr, int fq) const {
        const int row0 = u.pm * BM + wr * 64 + fr; const int col0 = u.pn * BM + wc * 32 + 8 * fq;
        const int kind = u.pn >= 12 ? 2 : ((u.pn >> 2) == 1 ? 1 : 0);
        const float qs = u.pn >= 8 ? 0.12751743082459868f : 1.0f;
        const int j0 = 16 * wc + 4 * fq;
        float rs[8]; load_rs(rs, rst, u.pm, wr * 64 + fr);
        if (kind == 0) {
#pragma unroll
            for (int ai = 0; ai < 2; ++ai) {
                f32x4 cs[4][2];
#pragma unroll
                for (int m = 0; m < 4; ++m) { const int row = row0 + ai * HALF + m * 16; const f32x4* rp = (const f32x4*)(rope + ((size_t)(row & 4095) * 64 + j0) * 2); cs[m][0] = rp[0]; cs[m][1] = rp[1]; }
                EPI_FENCE();
#pragma unroll
                for (int m = 0; m < 4; ++m) {
                    bf16_t* rowp = Z + (size_t)(row0 + ai * HALF + m * 16) * 5120 + col0;
                    const float sc = rs[4 * ai + m] * qs; const f32x4 c0 = cs[m][0] * sc, c1 = cs[m][1] * sc;
#pragma unroll
                    for (int bj = 0; bj < 2; ++bj) {
                        const f32x4 v0 = acc[ai][bj][m][0], v1 = acc[ai][bj][m][1];
                        u32x4 w;
                        w.x = cvt_pk_bf16(v0[0] * c0[0] - v0[1] * c0[1], v0[1] * c0[0] + v0[0] * c0[1]);
                        w.y = cvt_pk_bf16(v0[2] * c0[2] - v0[3] * c0[3], v0[3] * c0[2] + v0[2] * c0[3]);
                        w.z = cvt_pk_bf16(v1[0] * c1[0] - v1[1] * c1[1], v1[1] * c1[0] + v1[0] * c1[1]);
                        w.w = cvt_pk_bf16(v1[2] * c1[2] - v1[3] * c1[3], v1[3] * c1[2] + v1[2] * c1[3]);
                        *(u32x4*)(rowp + bj * HALF) = w;
                    }
                }
                EPI_FENCE();
            }
        } else {
            EPI_FENCE();
#pragma unroll
            for (int i = 0; i < 8; ++i) {
                const int ai = i >> 2, m = i & 3; bf16_t* rowp = Z + (size_t)(row0 + ai * HALF + m * 16) * 5120 + col0;
#pragma unroll
                for (int bj = 0; bj < 2; ++bj) {
                    f32x4 v0 = acc[ai][bj][m][0] * rs[i], v1 = acc[ai][bj][m][1] * rs[i];
                    if (kind == 2) {
#pragma unroll
                        for (int e = 0; e < 4; ++e) { v0[e] = gelu_tanh(v0[e]); v1[e] = gelu_tanh(v1[e]); }
                    }
                    u32x4 w; w.x = cvt_pk_bf16(v0[0], v0[1]); w.y = cvt_pk_bf16(v0[2], v0[3]); w.z = cvt_pk_bf16(v1[0], v1[1]); w.w = cvt_pk_bf16(v1[2], v1[3]);
                    *(u32x4*)(rowp + bj * HALF) = w;
                }
            }
        }
    }
};

struct EpiRelu2 {
    static constexpr bool PERM = true, AFTER_DRAIN = false;
    __device__ __forceinline__ void init(f32x4 (&acc)[2][2][4][2], const Unit&, int, int, int, int) const {
#pragma unroll
        for (int a = 0; a < 2; ++a)
#pragma unroll
            for (int b = 0; b < 2; ++b)
#pragma unroll
                for (int m = 0; m < 4; ++m)
#pragma unroll
                    for (int n = 0; n < 2; ++n) acc[a][b][m][n] = (f32x4){0.f, 0.f, 0.f, 0.f};
    }
    bf16_t* O; int ldc; RsTable rst;
    __device__ __forceinline__ void operator()(const f32x4 (&acc)[2][2][4][2], const Unit& u, int wr, int wc, int fr, int fq) const {
        const int row0 = u.pm * BM + wr * 64 + fr; const int col0 = u.pn * BM + wc * 32 + 8 * fq;
        float rs[8]; load_rs(rs, rst, u.pm, wr * 64 + fr);
        EPI_FENCE();
#pragma unroll
        for (int i = 0; i < 8; ++i) { const int ai = i >> 2, m = i & 3; bf16_t* rowp = O + (size_t)(row0 + ai * HALF + m * 16) * ldc + col0;
#pragma unroll
            for (int bj = 0; bj < 2; ++bj) { f32x4 v0 = acc[ai][bj][m][0] * rs[i], v1 = acc[ai][bj][m][1] * rs[i];
#pragma unroll
                for (int e = 0; e < 4; ++e) { const float a = fmaxf(v0[e], 0.f), b = fmaxf(v1[e], 0.f); v0[e] = a * a; v1[e] = b * b; }
                u32x4 w; w.x = cvt_pk_bf16(v0[0], v0[1]); w.y = cvt_pk_bf16(v0[2], v0[3]); w.z = cvt_pk_bf16(v1[0], v1[1]); w.w = cvt_pk_bf16(v1[2], v1[3]);
                *(u32x4*)(rowp + bj * HALF) = w; } }
    }
};

struct EpiResid {
    static constexpr bool PERM = true, AFTER_DRAIN = false;
    float* out; bf16_t* xb; float* ss; int wf32;
    static constexpr unsigned LDC = 2048;
    __device__ __forceinline__ static float blo(unsigned w) { return __builtin_bit_cast(float, w << 16); }
    __device__ __forceinline__ static float bhi(unsigned w) { return __builtin_bit_cast(float, w & 0xffff0000u); }
    __device__ __forceinline__ void init(f32x4 (&acc)[2][2][4][2], const Unit& u, int wr, int wc, int fr, int fq) const {
        const int row0 = u.pm * BM + wr * 64 + fr; const int col0 = u.pn * BM + wc * 32 + 8 * fq;
        const unsigned ob0 = ((unsigned)row0 * LDC + (unsigned)col0) * 2u; const char* bb = (const char*)xb;
#pragma unroll
        for (int ai = 0; ai < 2; ++ai)
#pragma unroll
            for (int m = 0; m < 4; ++m) { const unsigned o = ob0 + (unsigned)((ai * HALF + m * 16) * LDC * 2);
#pragma unroll
                for (int bj = 0; bj < 2; ++bj) { const u32x4 w = *(const u32x4*)(bb + o + bj * HALF * 2);
                    acc[ai][bj][m][0] = (f32x4){blo(w.x), bhi(w.x), blo(w.y), bhi(w.y)}; acc[ai][bj][m][1] = (f32x4){blo(w.z), bhi(w.z), blo(w.w), bhi(w.w)}; } }
    }
    __device__ __forceinline__ void operator()(const f32x4 (&acc)[2][2][4][2], const Unit& u, int wr, int wc, int fr, int fq) const {
        const int row0 = u.pm * BM + wr * 64 + fr; const int col0 = u.pn * BM + wc * 32 + 8 * fq;
        const unsigned ob0 = ((unsigned)row0 * LDC + (unsigned)col0) * 4u;
        char* ob = (char*)out; char* xbb = (char*)xb;
#pragma unroll
        for (int ai = 0; ai < 2; ++ai) { float sm[4];
#pragma unroll
            for (int m = 0; m < 4; ++m) { const unsigned o = ob0 + (unsigned)((ai * HALF + m * 16) * LDC * 4); float s = 0.f;
#pragma unroll
                for (int bj = 0; bj < 2; ++bj) {
                    const f32x4 o0 = acc[ai][bj][m][0], o1 = acc[ai][bj][m][1];
                    s += (o0[0] * o0[0] + o0[1] * o0[1]) + (o0[2] * o0[2] + o0[3] * o0[3]) + (o1[0] * o1[0] + o1[1] * o1[1]) + (o1[2] * o1[2] + o1[3] * o1[3]);
                    if (wf32) { *(f32x4*)(ob + o + bj * HALF * 4) = o0; *(f32x4*)(ob + o + bj * HALF * 4 + 16) = o1; }
                    else { u32x4 w; w.x = cvt_pk_bf16(o0[0], o0[1]); w.y = cvt_pk_bf16(o0[2], o0[3]); w.z = cvt_pk_bf16(o1[0], o1[1]); w.w = cvt_pk_bf16(o1[2], o1[3]);
                           *(u32x4*)(xbb + (o >> 1) + bj * HALF * 2) = w; } }
                s = sum_16_32(s);
                sm[m] = s; }
            ss[(size_t)(4 * u.pn + wc) * 16384 + u.pm * BM + wr * 64 + ai * HALF + 16 * fq + fr] = fq == 0 ? sm[0] : (fq == 1 ? sm[1] : (fq == 2 ? sm[2] : sm[3])); }
    }
};
template <class Epi, class Sched, bool ALIGN_EPI = false, bool SP2 = false>
__device__ __forceinline__ void gemm_phase(PG8_LAS unsigned char* lds, const Gemm g, const Sched& S, const Epi& E, const int wid_in) {
    int wid = wid_in; asm volatile("" : "+s"(wid));
    const int lane_ = fresh_lane();
    const int lane = lane_, tid = wid * 64 + lane,
               wr = wid >> 2, wc = wid & 3, fr = lane & 15, fq = lane >> 4;
    const int K = g.K, nt = K / BK;
    unsigned voffA[2], voffB[2];
#pragma unroll
    for (int i = 0; i < 2; ++i) { int R, C; stage_rc(tid * 16 + i * 8192, R, C); const int Rb = Epi::PERM ? ((R & ~31) + perm32(R & 31)) : R;
        voffA[i] = (unsigned)(R * g.lda + C) * 2u; voffB[i] = (unsigned)(Rb * K + C) * 2u; }
    const size_t kstep = (size_t)(BK * 2);
    const size_t hstep = (size_t)HALF * K * 2, tstep = 2 * hstep;
    const size_t hstepA = (size_t)HALF * g.lda * 2, tstepA = 2 * hstepA;
    const unsigned ldsw = (unsigned)wid * 1024u;
    const int aoff = lds_byte(wr * 64 + fr, fq * 8), boff = lds_byte(wc * 32 + fr, fq * 8);
#define PG8_SA(b, h) (((b) * 2 + (h)) * HTB)
#define PG8_SB(b, h) ((4 + (b) * 2 + (h)) * HTB)
#define PG8_STAGE(bufoff, gbase, voff) do { _Pragma("unroll") for (int _i = 0; _i < 2; ++_i) \
        __builtin_amdgcn_global_load_lds((const unsigned*)((const char*)(gbase) + (voff)[_i]), (PG8_LAS unsigned*)(lds + (bufoff) + ldsw + _i * 8192), 16, 0, 0); } while (0)
#define PG8_LDA(dst, b, h) do { _Pragma("unroll") for (int m = 0; m < 4; ++m) _Pragma("unroll") for (int k = 0; k < 2; ++k) dst[m][k] = *(const PG8_LAS bf16x8*)(lds + PG8_SA(b, h) + aoff + m * 2048 + k * 1024); } while (0)
#define PG8_LDB(dst, b, h) do { _Pragma("unroll") for (int n = 0; n < 2; ++n) _Pragma("unroll") for (int k = 0; k < 2; ++k) dst[n][k] = *(const PG8_LAS bf16x8*)(lds + PG8_SB(b, h) + boff + n * 2048 + k * 1024); } while (0)
#define PG8_MMA(ai, bj, At, Bt) do { __builtin_amdgcn_s_setprio(1); _Pragma("unroll") for (int m = 0; m < 4; ++m) _Pragma("unroll") for (int n = 0; n < 2; ++n) _Pragma("unroll") for (int k = 0; k < 2; ++k) \
        acc[ai][bj][m][n] = __builtin_amdgcn_mfma_f32_16x16x32_bf16(Bt[n][k], At[m][k], acc[ai][bj][m][n], 0, 0, 0); __builtin_amdgcn_s_setprio(0); } while (0)
#define PG8_WAIT_V(n) asm volatile("s_waitcnt vmcnt(" #n ")" ::: "memory")
#define PG8_WAIT_L(n) asm volatile("s_waitcnt lgkmcnt(" #n ")" ::: "memory")
#define PG8_BAR __builtin_amdgcn_s_barrier()
#define PG8_SCHED __builtin_amdgcn_sched_barrier(0)
    Unit cur, nxt; int ui = 0;
    if (!S.next(0, cur)) return;
    f32x4 acc[2][2][4][2];
    E.init(acc, cur, wr, wc, fr, fq);
    bf16x8 At[4][2], B0[2][2], B1[2][2];
    const char* cA = (const char*)g.A + (size_t)cur.pm * tstepA; const char* cB = (const char*)g.Bt + (size_t)cur.pn * tstep;
    S.a_ready(cur);
    if constexpr (SP2) {
        PG8_STAGE(PG8_SB(0, 0), cB, voffB); PG8_STAGE(PG8_SB(0, 1), cB + hstep, voffB); PG8_STAGE(PG8_SA(0, 0), cA, voffA); PG8_STAGE(PG8_SA(0, 1), cA + hstepA, voffA);
        if (wr == 1) PG8_BAR;
        PG8_WAIT_V(2); PG8_BAR;
        PG8_STAGE(PG8_SB(1, 0), cB + kstep, voffB); PG8_STAGE(PG8_SA(1, 0), cA + kstep, voffA); PG8_STAGE(PG8_SB(1, 1), cB + hstep + kstep, voffB);
        PG8_WAIT_V(6); PG8_BAR;
    } else {
        PG8_STAGE(PG8_SB(0, 0), cB, voffB); PG8_STAGE(PG8_SA(0, 0), cA, voffA); PG8_STAGE(PG8_SB(0, 1), cB + hstep, voffB); PG8_STAGE(PG8_SA(0, 1), cA + hstepA, voffA);
        if (wr == 1) PG8_BAR;
        PG8_WAIT_V(4); PG8_BAR;
        PG8_STAGE(PG8_SB(1, 0), cB + kstep, voffB); PG8_STAGE(PG8_SA(1, 0), cA + kstep, voffA); PG8_STAGE(PG8_SB(1, 1), cB + hstep + kstep, voffB);
        PG8_WAIT_V(6); PG8_BAR;
    }
    for (;;) {
        const bool has_next = S.next(ui + 1, nxt);
        const char* nA = has_next ? (const char*)g.A + (size_t)nxt.pm * tstepA : cA; const char* nB = has_next ? (const char*)g.Bt + (size_t)nxt.pn * tstep : cB;
        for (int t = 0; t < nt; t += 2) {
            const bool last = (t == nt - 2);
            const char* a1 = cA + (size_t)(t + 1) * kstep;
            const char* a2 = last ? nA : cA + (size_t)(t + 2) * kstep; const char* b2 = last ? nB : cB + (size_t)(t + 2) * kstep;
            const char* a3 = a2 + kstep; const char* b3 = b2 + kstep;
            if (last && has_next) S.a_ready(nxt);
            if constexpr (SP2) {
            PG8_LDB(B0, 0, 0); PG8_LDB(B1, 0, 1); PG8_SCHED; PG8_LDA(At, 0, 0); PG8_STAGE(PG8_SA(1, 1), a1 + hstepA, voffA);
            PG8_WAIT_V(8); PG8_WAIT_L(0); PG8_BAR; PG8_MMA(0, 0, At, B0); PG8_MMA(0, 1, At, B1); PG8_BAR; PG8_SCHED;
            PG8_LDA(At, 0, 1); PG8_STAGE(PG8_SB(0, 0), b2, voffB); PG8_STAGE(PG8_SB(0, 1), b2 + hstep, voffB); PG8_STAGE(PG8_SA(0, 0), a2, voffA);
            PG8_WAIT_V(8); PG8_WAIT_L(0); PG8_BAR; PG8_MMA(1, 0, At, B0); PG8_MMA(1, 1, At, B1); PG8_BAR; PG8_SCHED;
            PG8_LDB(B0, 1, 0); PG8_LDB(B1, 1, 1); PG8_SCHED; PG8_LDA(At, 1, 0); PG8_STAGE(PG8_SA(0, 1), a2 + hstepA, voffA);
            PG8_WAIT_V(8); PG8_WAIT_L(0); PG8_BAR; PG8_MMA(0, 0, At, B0); PG8_MMA(0, 1, At, B1); PG8_BAR; PG8_SCHED;
            PG8_LDA(At, 1, 1); PG8_STAGE(PG8_SB(1, 0), b3, voffB); PG8_STAGE(PG8_SB(1, 1), b3 + hstep, voffB); PG8_STAGE(PG8_SA(1, 0), a3, voffA);
            PG8_WAIT_V(8); PG8_WAIT_L(0); PG8_BAR; PG8_MMA(1, 0, At, B0); PG8_MMA(1, 1, At, B1); PG8_BAR; PG8_SCHED;
            } else {
            PG8_LDB(B0, 0, 0); PG8_SCHED; PG8_LDA(At, 0, 0); PG8_STAGE(PG8_SA(1, 1), a1 + hstepA, voffA);
            PG8_WAIT_L(8); PG8_BAR; PG8_WAIT_L(0); PG8_MMA(0, 0, At, B0); PG8_BAR; PG8_SCHED;
            PG8_LDB(B1, 0, 1); PG8_STAGE(PG8_SB(0, 0), b2, voffB);
            PG8_BAR; PG8_WAIT_L(0); PG8_MMA(0, 1, At, B1); PG8_BAR;
            PG8_LDA(At, 0, 1); PG8_STAGE(PG8_SA(0, 0), a2, voffA);
            PG8_BAR; PG8_WAIT_L(0); PG8_MMA(1, 0, At, B0); PG8_BAR; PG8_SCHED;
            PG8_STAGE(PG8_SB(0, 1), b2 + hstep, voffB);
            PG8_WAIT_V(6); PG8_BAR; PG8_MMA(1, 1, At, B1); PG8_BAR;
            PG8_LDB(B0, 1, 0); PG8_SCHED; PG8_LDA(At, 1, 0); PG8_STAGE(PG8_SA(0, 1), a2 + hstepA, voffA);
            PG8_WAIT_L(8); PG8_BAR; PG8_WAIT_L(0); PG8_MMA(0, 0, At, B0); PG8_BAR; PG8_SCHED;
            PG8_LDB(B1, 1, 1); PG8_STAGE(PG8_SB(1, 0), b3, voffB);
            PG8_BAR; PG8_WAIT_L(0); PG8_MMA(0, 1, At, B1); PG8_BAR;
            PG8_LDA(At, 1, 1); PG8_STAGE(PG8_SA(1, 0), a3, voffA);
            PG8_BAR; PG8_WAIT_L(0); PG8_MMA(1, 0, At, B0); PG8_BAR; PG8_SCHED;
            PG8_STAGE(PG8_SB(1, 1), b3 + hstep, voffB);
            PG8_WAIT_V(6); PG8_BAR; PG8_MMA(1, 1, At, B1); PG8_BAR;
            }
        }
        if constexpr (ALIGN_EPI) { if (wr == 0) PG8_BAR; }
        if constexpr (!Epi::AFTER_DRAIN) { E(acc, cur, wr, wc, fr, fq); S.done(cur); }
        if (!has_next) break;
        E.init(acc, nxt, wr, wc, fr, fq);
        cur = nxt; cA = nA; cB = nB; ++ui;
        if constexpr (ALIGN_EPI) { if (wr == 1) PG8_BAR; }
    }
    PG8_WAIT_V(0);
    if constexpr (!ALIGN_EPI) { if (wr == 0) PG8_BAR; }
    PG8_BAR;
    if constexpr (Epi::AFTER_DRAIN) { E.fused(acc, cur, wr, wc, fr, fq, lds, wid, lane); S.done(cur); }
#undef PG8_SA
#undef PG8_SB
#undef PG8_STAGE
#undef PG8_LDA
#undef PG8_LDB
#undef PG8_MMA
#undef PG8_WAIT_V
#undef PG8_WAIT_L
#undef PG8_BAR
#undef PG8_SCHED
}
}

constexpr int NWAVES = 8;
constexpr int BATCH = 4, SEQ = 4096, DM = 2048, DEPTH = 2, M = BATCH * SEQ;
constexpr int INW = 5120, DFF = 8192, HD = 128, NH = 8;
#ifndef WGM_IN
#define WGM_IN 4
#endif
#ifndef WGM_OUT
#define WGM_OUT 4
#endif
#ifndef WGM_UP
#define WGM_UP 4
#endif
#ifndef WGM_DN
#define WGM_DN 4
#endif
constexpr int LDS_MAIN = 147456, LDS_BYTES = LDS_MAIN + 64;

constexpr size_t MiB = 1u << 20;
constexpr size_t WS_WIN = 0;
constexpr size_t WS_WOUT = 40 * MiB;
constexpr size_t WS_WUP = 56 * MiB;
constexpr size_t WS_WDN = 120 * MiB;
constexpr size_t WS_ACT = 184 * MiB;
constexpr size_t WS_Z = 248 * MiB;
constexpr size_t WS_ON = 408 * MiB;
constexpr size_t WS_U = WS_Z;
constexpr size_t WS_LSE = 504 * MiB;
constexpr size_t WS_ROPE = 506 * MiB;
constexpr size_t WS_WSP = 508 * MiB;
constexpr size_t WS_BAR = 509 * MiB;
constexpr size_t WS_SS = 510 * MiB;
constexpr size_t WS_END = 512 * MiB;

#define LAS __attribute__((address_space(3)))
#define GAS1 __attribute__((address_space(1)))
typedef unsigned short bf16;
typedef unsigned v4u __attribute__((ext_vector_type(4)));
typedef unsigned v2u __attribute__((ext_vector_type(2)));
typedef float f32x4 __attribute__((ext_vector_type(4)));
typedef short bf16x8 __attribute__((ext_vector_type(8)));
typedef short s16x4 __attribute__((ext_vector_type(4)));
#define LDS_WAIT() asm volatile("s_waitcnt lgkmcnt(0)" ::: "memory")

__device__ __forceinline__ unsigned pk2(float lo, float hi) { return pg8::cvt_pk_bf16(lo, hi); }
__device__ __forceinline__ float bf_lo(unsigned w) { return __uint_as_float(w << 16); }
__device__ __forceinline__ float bf_hi(unsigned w) { return __uint_as_float(w & 0xffff0000u); }
__device__ __forceinline__ float wave_sum(float v) {
#pragma unroll
    for (int o = 1; o < 64; o <<= 1) v += __shfl_xor(v, o);
    return v;
}
__device__ __forceinline__ s16x4 tr_read(const LAS unsigned char* p) {
    typedef short v4i16_t __attribute__((ext_vector_type(4)));
    return __builtin_bit_cast(s16x4, __builtin_amdgcn_ds_read_tr16_b64_v4i16((LAS v4i16_t*)p));
}
#define MFMA16(a, b, c) __builtin_amdgcn_mfma_f32_16x16x32_bf16((a), (b), (c), 0, 0, 0)

struct Args {
    const float* x; const float* norm1_g; const float* w_in; const float* ln_g; const float* ln_b; const float* w_sp; const float* b_sp;
    const float* w_out; const float* norm2_g; const float* w_up; const float* w_down; const float* final_g;
    float* out; unsigned char* ws;
};

__device__ __forceinline__ void p0_transpose_item(const float* W, int K, int N, bf16* WT, int item, bool inproj, const float* gk, LAS float* scr, int lane) {
    const int nblk = N / 64, kb = item / nblk, nb = item % nblk, k0 = 64 * kb, n0 = 64 * nb;
    int sc = n0 + lane, cl = lane;
    if (inproj && n0 < 3072) {
        const int sec = n0 >> 10;
        if (sec == 1) sc = n0 + 1024 + lane;
        else { const int hb = (sec == 0 ? 1024 : 0) + (n0 & 1023 & ~127); sc = hb + ((n0 & 127) >> 1) + (lane & 31) + 64 * (lane >> 5); cl = 2 * (lane & 31) + (lane >> 5); }
    }
    const GAS1 float* src = (const GAS1 float*)(W + (size_t)k0 * N + sc);
    float tv[64];
#pragma unroll
    for (int kk = 0; kk < 64; ++kk) tv[kk] = src[(size_t)kk * N];
#pragma unroll
    for (int kk = 0; kk < 64; ++kk) scr[kk * 65 + cl] = tv[kk];
    LDS_WAIT(); asm volatile("" ::: "memory");
    const int c = lane >> 3;
    f32x4 g0 = (f32x4){1.f, 1.f, 1.f, 1.f}, g1 = g0;
    if (gk) { g0 = *(const f32x4*)(gk + k0 + 8 * c); g1 = *(const f32x4*)(gk + k0 + 8 * c + 4); }
#pragma unroll
    for (int j = 0; j < 8; ++j) { const int n = (lane & 7) + 8 * j; const LAS float* s = scr + (8 * c) * 65 + n;
        v4u o; o.x = pk2(s[0 * 65] * g0.x, s[1 * 65] * g0.y); o.y = pk2(s[2 * 65] * g0.z, s[3 * 65] * g0.w); o.z = pk2(s[4 * 65] * g1.x, s[5 * 65] * g1.y); o.w = pk2(s[6 * 65] * g1.z, s[7 * 65] * g1.w);
        *(GAS1 v4u*)(WT + (size_t)(n0 + n) * K + k0 + 8 * c) = o; }
    LDS_WAIT(); asm volatile("" ::: "memory");
}
__device__ __forceinline__ void rope_entry(int pos, int j, float& co, float& si) {
    double f = 1.0; double rr = 0.8659643233600653; int e = j;
    for (int b = 0; b < 6; ++b) { if (e & 1) f *= rr; rr *= rr; e >>= 1; }
    const double x = (double)pos * f;
    const double kq = __builtin_rint(x * 0.6366197723675814);
    double r = __builtin_fma(-kq, 1.5707963267948966, x); r = __builtin_fma(-kq, 6.123233995736766e-17, r);
    const double r2 = r * r;
    double s = -1.0 / 1307674368000.0; s = s * r2 + 1.0 / 6227020800.0; s = s * r2 - 1.0 / 39916800.0; s = s * r2 + 1.0 / 362880.0; s = s * r2 - 1.0 / 5040.0; s = s * r2 + 1.0 / 120.0; s = s * r2 - 1.0 / 6.0; s = s * r2 * r + r;
    double c = 1.0 / 20922789888000.0; c = c * r2 - 1.0 / 87178291200.0; c = c * r2 + 1.0 / 479001600.0; c = c * r2 - 1.0 / 3628800.0; c = c * r2 + 1.0 / 40320.0; c = c * r2 - 1.0 / 720.0; c = c * r2 + 1.0 / 24.0; c = c * r2 - 0.5; c = c * r2 + 1.0;
    const int q = ((int)kq) & 3;
    const double cc = (q == 0) ? c : (q == 1) ? -s : (q == 2) ? -c : s;
    const double ss = (q == 0) ? s : (q == 1) ? c : (q == 2) ? -s : -c;
    co = (float)cc; si = (float)ss;
}
__device__ __forceinline__ void rms_rows(const float* X, const float* g, bf16* H, float* OF, int gw, int NGW, int lane) {
    for (int m = gw; m < M; m += NGW) {
        const f32x4* xr = (const f32x4*)(X + (size_t)m * DM) + lane;
        f32x4 v[8]; float ss = 0.f;
#pragma unroll
        for (int j = 0; j < 8; ++j) { v[j] = xr[64 * j]; ss += (v[j].x * v[j].x + v[j].y * v[j].y) + (v[j].z * v[j].z + v[j].w * v[j].w); }
        const float rs = rsqrtf(wave_sum(ss) * (1.0f / DM) + 1e-6f);
        const f32x4* gr = (const f32x4*)g + lane;
        if (H) { v2u* o = (v2u*)(H + (size_t)m * DM) + lane;
#pragma unroll
            for (int j = 0; j < 8; ++j) { const f32x4 gg = gr[64 * j]; v2u w; w.x = pk2(v[j].x * rs * gg.x, v[j].y * rs * gg.y); w.y = pk2(v[j].z * rs * gg.z, v[j].w * rs * gg.w); o[64 * j] = w; }
        } else { f32x4* o = (f32x4*)(OF + (size_t)m * DM) + lane;
#pragma unroll
            for (int j = 0; j < 8; ++j) { const f32x4 gg = gr[64 * j]; o[64 * j] = v[j] * rs * gg; }
        }
    }
}

__device__ __forceinline__ void cast_rows(const float* X, bf16* H, float* ss, int gw, int NGW, int lane) {
    for (int m = gw; m < M; m += 2 * NGW) {
        const int m1 = m + NGW;
        const f32x4* xr0 = (const f32x4*)(X + (size_t)m * DM) + lane; const f32x4* xr1 = (const f32x4*)(X + (size_t)m1 * DM) + lane;
        f32x4 v0[8], v1[8];
#pragma unroll
        for (int j = 0; j < 8; ++j) { v0[j] = xr0[64 * j]; v1[j] = xr1[64 * j]; }
        v2u* o0 = (v2u*)(H + (size_t)m * DM) + lane; v2u* o1 = (v2u*)(H + (size_t)m1 * DM) + lane;
        float s0 = 0.f, s1 = 0.f;
#pragma unroll
        for (int j = 0; j < 8; ++j) { const f32x4 a = v0[j], b = v1[j];
            s0 += (a.x * a.x + a.y * a.y) + (a.z * a.z + a.w * a.w); s1 += (b.x * b.x + b.y * b.y) + (b.z * b.z + b.w * b.w);
            v2u w; w.x = pk2(a.x, a.y); w.y = pk2(a.z, a.w); o0[64 * j] = w; w.x = pk2(b.x, b.y); w.y = pk2(b.z, b.w); o1[64 * j] = w; }
        s0 = wave_sum(s0); s1 = wave_sum(s1);
        if (lane < 32) { ss[(size_t)lane * M + m] = lane == 0 ? s0 : 0.f; ss[(size_t)lane * M + m1] = lane == 0 ? s1 : 0.f; }
    }
}

__device__ __forceinline__ void final_rows(const bf16* XB, const float* ss, const float* g, float* OF, int gw, int NGW, int lane) {
    for (int m = gw; m < M; m += NGW) {
        const v4u* xr = (const v4u*)(XB + (size_t)m * DM) + lane; f32x4* o = (f32x4*)(OF + (size_t)m * DM); const f32x4* gr = (const f32x4*)g;
        const float rs = rsqrtf(ss[m] * (1.0f / DM) + 1e-6f);
#pragma unroll
        for (int j = 0; j < 4; ++j) { const v4u w = xr[64 * j]; const int c = 2 * (lane + 64 * j); const f32x4 g0 = gr[c], g1 = gr[c + 1];
            o[c] = (f32x4){bf_lo(w.x) * rs * g0.x, bf_hi(w.x) * rs * g0.y, bf_lo(w.y) * rs * g0.z, bf_hi(w.y) * rs * g0.w};
            o[c + 1] = (f32x4){bf_lo(w.z) * rs * g1.x, bf_hi(w.z) * rs * g1.y, bf_lo(w.w) * rs * g1.z, bf_hi(w.w) * rs * g1.w}; }
    }
}

__device__ __forceinline__ void final_tiles(LAS unsigned char* lds, const bf16* XB, const float* ss, const float* g, float* OF, int G, int bx, int tid) {
    pg8::StaticOrder S; S.init(M, DM, G, bx, WGM_DN); pg8::Unit u;
    const pg8::RsTable T = pg8::rs_prepass(lds + 131072, ss, S, tid);
    for (int i = 0; S.next(i, u); ++i) {
        const int k = u.pm == T.pm[0] ? 0 : (u.pm == T.pm[1] ? 1 : (u.pm == T.pm[2] ? 2 : 3));
#pragma unroll 4
        for (int q = 0; q < 16; ++q) {
            const int c = tid + 512 * q, lr = c >> 5, row = u.pm * 256 + lr, col = u.pn * 256 + (c & 31) * 8;
            const v4u w = *(const v4u*)(XB + (size_t)row * DM + col);
            const float rs = T.tab[k * 256 + lr];
            const f32x4 g0 = *(const f32x4*)(g + col), g1 = *(const f32x4*)(g + col + 4);
            f32x4* o = (f32x4*)(OF + (size_t)row * DM + col);
            o[0] = (f32x4){bf_lo(w.x) * rs * g0.x, bf_hi(w.x) * rs * g0.y, bf_lo(w.y) * rs * g0.z, bf_hi(w.y) * rs * g0.w};
            o[1] = (f32x4){bf_lo(w.z) * rs * g1.x, bf_hi(w.z) * rs * g1.y, bf_lo(w.w) * rs * g1.z, bf_hi(w.w) * rs * g1.w};
        }
    }
}

constexpr int KV_STRIDE = 288;
constexpr int LDS_V_OFF = 256 * KV_STRIDE;
struct AttnPre { v4u k[8], v[8]; bf16x8 q[4]; };
struct AttnUid { int bh, br, d, dl, r, n, reuse, sx; };
__device__ __forceinline__ AttnUid attn_decode_chain(int vx, int vr, int idx) {
    AttnUid u; const int cs = vr + 32 * (idx >> 2), k = idx & 3, within = cs % 24, q = within & 7;
    u.bh = 4 * vx + cs / 24; u.br = within >> 3; u.dl = 2 * u.br; u.d = 1 << u.dl;
    if (u.br == 0) { u.r = 0; u.n = 4 * q + k; u.reuse = k > 0; }
    else if (u.br == 1) { u.r = q >> 1; u.n = 4 * (q & 1) + k; u.reuse = k > 0; }
    else { u.r = 2 * q + (k >> 1); u.n = k & 1; u.reuse = k & 1; }
    u.sx = 128 * (k & 1);
    return u;
}
__device__ __forceinline__ void attn_load(AttnPre& P, const bf16* Z, const AttnUid& u, int tid, int wave, int lane) {
    const int b = u.bh >> 3, h = u.bh & 7;
    const bf16* Zb = Z + (size_t)b * SEQ * INW;
#pragma unroll
    for (int i = 0; i < 8; ++i) {
        const int c = tid + 512 * i, j = c >> 4, ch = c & 15;
        const int I = (u.n - 1) * 128 + j;
        if (i < 4 && u.reuse) continue;
        if (I >= 0) { const bf16* p = Zb + (size_t)(I * u.d + u.r) * INW + h * HD + ch * 8; P.k[i] = *(const v4u*)p; P.v[i] = *(const v4u*)(p + 1024); }
        else { P.k[i] = (v4u){0u, 0u, 0u, 0u}; P.v[i] = P.k[i]; }
    }
    const int fr = lane & 15, fq = lane >> 4;
    const int qsub = u.n * 128 + 16 * wave + fr;
    const bf16* qp = Zb + (size_t)(qsub * u.d + u.r) * INW + 2048 + h * HD + 8 * fq;
#pragma unroll
    for (int ks = 0; ks < 4; ++ks) P.q[ks] = *(const bf16x8*)(qp + 32 * ks);
}
__device__ __forceinline__ void attn_stage(LAS unsigned char* lds, const AttnPre& P, const AttnUid& u, int tid) {
#pragma unroll
    for (int i = 0; i < 8; ++i) {
        if (i < 4 && u.reuse) continue;
        const int c = tid + 512 * i, j = (c >> 4) ^ u.sx, ch = c & 15;
        *(LAS v4u*)(lds + j * KV_STRIDE + ch * 16) = P.k[i];
        *(LAS v4u*)(lds + LDS_V_OFF + j * KV_STRIDE + ch * 16) = P.v[i];
    }
}
__device__ __forceinline__ void attn_compute(LAS unsigned char* lds, const bf16x8 (&qf)[4], const AttnUid& u, bf16* ON, float* LSE, int wave, int lane) {
    const int fr = lane & 15, fq = lane >> 4;
    const int qi = 16 * wave + fr;
    const int qsub = u.n * 128 + qi;
    f32x4 S[10];
    const LAS unsigned char* kb = lds + fr * KV_STRIDE + 16 * fq;
    bf16x8 kf[3][4];
#define ATT_LOADK(buf, T) do { _Pragma("unroll") for (int ks_ = 0; ks_ < 4; ++ks_) kf[buf][ks_] = *(const LAS bf16x8*)(kb + ((16 * (wave + (T))) ^ u.sx) * KV_STRIDE + 64 * ks_); } while (0)
    ATT_LOADK(0, 0); ATT_LOADK(1, 1);
#pragma unroll
    for (int T = 0; T < 9; ++T) {
        if (T + 2 < 9) ATT_LOADK((T + 2) % 3, T + 2);
        __builtin_amdgcn_sched_barrier(0);
        S[T] = (f32x4){0.f, 0.f, 0.f, 0.f};
#pragma unroll
        for (int ks = 0; ks < 4; ++ks) S[T] = MFMA16(kf[T % 3][ks], qf[ks], S[T]);
        __builtin_amdgcn_sched_barrier(0);
    }
#undef ATT_LOADK
    S[9] = (f32x4){0.f, 0.f, 0.f, 0.f};
    const float NEG = -1.0e30f;
#pragma unroll
    for (int i = 0; i < 4; ++i) { if (4 * fq + i < fr) S[0][i] = NEG; if (4 * fq + i > fr) S[8][i] = NEG; }
    if (u.n == 0) {
#pragma unroll
        for (int T = 0; T < 9; ++T)
#pragma unroll
            for (int i = 0; i < 4; ++i) if (16 * wave + 16 * T + 4 * fq + i < 128) S[T][i] = NEG;
    }
    float mx = NEG;
#pragma unroll
    for (int T = 0; T < 9; ++T) mx = fmaxf(mx, fmaxf(fmaxf(S[T][0], S[T][1]), fmaxf(S[T][2], S[T][3])));
    mx = pg8::max_16_32(mx);
    float l = 0.f;
#pragma unroll
    for (int T = 0; T < 9; ++T)
#pragma unroll
        for (int i = 0; i < 4; ++i) { const float p = __builtin_amdgcn_exp2f(S[T][i] - mx); S[T][i] = p; l += p; }
    l = pg8::sum_16_32(l);
    const float inv = 1.0f / l;
    bf16x8 pf[5];
#pragma unroll
    for (int s = 0; s < 5; ++s) { v4u w; w.x = pk2(S[2 * s][0], S[2 * s][1]); w.y = pk2(S[2 * s][2], S[2 * s][3]); w.z = pk2(S[2 * s + 1][0], S[2 * s + 1][1]); w.w = pk2(S[2 * s + 1][2], S[2 * s + 1][3]); pf[s] = __builtin_bit_cast(bf16x8, w); }
    const int i16 = lane & 15;
    const LAS unsigned char* vb = lds + LDS_V_OFF + (4 * fq + (i16 >> 2)) * KV_STRIDE + 8 * (i16 & 3);
    const int pp = u.r * (SEQ >> u.dl) + qsub;
    bf16* op = ON + ((size_t)(u.br * 32 + u.bh) * SEQ + pp) * HD + 4 * fq;
    v2u wprev = (v2u){0u, 0u};
    bf16x8 vf[2][5];
#define ATT_LOADV(buf, dt_) do { _Pragma("unroll") for (int s_ = 0; s_ < 5; ++s_) { const s16x4 lo_ = tr_read(vb + ((16 * wave + 32 * s_) ^ u.sx) * KV_STRIDE + 32 * (dt_)); \
        const s16x4 hi_ = (s_ < 4) ? tr_read(vb + ((16 * wave + 32 * s_ + 16) ^ u.sx) * KV_STRIDE + 32 * (dt_)) : lo_; vf[buf][s_] = __builtin_shufflevector(lo_, hi_, 0, 1, 2, 3, 4, 5, 6, 7); } } while (0)
    ATT_LOADV(0, 0);
#pragma unroll
    for (int dt = 0; dt < 8; ++dt) {
        if (dt + 1 < 8) ATT_LOADV((dt + 1) & 1, dt + 1);
        __builtin_amdgcn_sched_barrier(0);
        f32x4 O = (f32x4){0.f, 0.f, 0.f, 0.f};
#pragma unroll
        for (int s = 0; s < 5; ++s) O = MFMA16(vf[dt & 1][s], pf[s], O);
        v2u w; w.x = pk2(O[0] * inv, O[1] * inv); w.y = pk2(O[2] * inv, O[3] * inv);
        if ((dt & 1) == 0) wprev = w;
        else {
            const auto rx = __builtin_amdgcn_permlane16_swap(wprev.x, w.x, false, false); const auto ry = __builtin_amdgcn_permlane16_swap(wprev.y, w.y, false, false);
            const v4u q = (v4u){rx[0], ry[0], rx[1], ry[1]};
            *(v4u*)(op - 4 * fq + 4 * (fq & ~1) + 16 * (dt - 1 + (fq & 1))) = q;
        }
        __builtin_amdgcn_sched_barrier(0);
    }
#undef ATT_LOADV
    if (fq == 0) LSE[(size_t)(u.br * 32 + u.bh) * SEQ + pp] = mx + __builtin_amdgcn_logf(l);
}

struct GmlpPre { v4u v[4]; v4u u[4]; };
__device__ __forceinline__ void gmlp_load(GmlpPre& P, const bf16* Z, int uid, int tid, int wave, int lane) {
    const int g = uid & 7, c = (uid >> 3) & 31, b = uid >> 8;
    const size_t row0 = (size_t)b * SEQ + 128 * c;
    const v4u* vp = (const v4u*)(Z + (row0 + (tid >> 2)) * INW + 4096 + g * HD + 32 * (tid & 3));
#pragma unroll
    for (int k = 0; k < 4; ++k) P.v[k] = vp[k];
    const int fq_ = lane >> 4;
    const bf16* up = Z + (row0 + 16 * wave + (lane & 15)) * INW + 3072 + g * HD + 4 * (fq_ & ~1) + 16 * (fq_ & 1);
#pragma unroll
    for (int p = 0; p < 4; ++p) P.u[p] = *(const v4u*)(up + 32 * p);
}
__device__ __forceinline__ void gmlp_phase(LAS unsigned char* lds, bf16* Z, const bf16* WSP, const float* bsp, const float* lng, const float* lnb, int bx, int G, int tid, int wave, int lane) {
    const int fr = lane & 15, fq = lane >> 4, i16 = lane & 15;
    const int g = bx & 7, t = 16 * wave + fr, d0 = 32 * (tid & 3);
    bf16x8 wf[4];
    { const bf16* wp = WSP + ((size_t)g * 128 + t) * 128 + 4 * fq;
#pragma unroll
      for (int ks = 0; ks < 4; ++ks) { const v2u wlo = *(const v2u*)(wp + 32 * ks), whi = *(const v2u*)(wp + 32 * ks + 16); wf[ks] = __builtin_bit_cast(bf16x8, (v4u){wlo.x, wlo.y, whi.x, whi.y}); } }
    const float bs = bsp[g * 128 + t];
    f32x4 lg[8], lb[8];
#pragma unroll
    for (int k = 0; k < 8; ++k) { lg[k] = *(const f32x4*)(lng + g * HD + d0 + 4 * k); lb[k] = *(const f32x4*)(lnb + g * HD + d0 + 4 * k); }
    const LAS unsigned char* vb = lds + (4 * fq + (i16 >> 2)) * KV_STRIDE + 8 * (i16 & 3);
    const int nks = (wave >> 1) + 1;
    GmlpPre P;
    int uid = bx;
    if (uid < 1024) gmlp_load(P, Z, uid, tid, wave, lane);
#pragma nounroll
    for (; uid < 1024; uid += G) {
        {
            float x[32]; float sum = 0.f;
#pragma unroll
            for (int k = 0; k < 4; ++k) { const v4u w = P.v[k];
                x[8 * k + 0] = bf_lo(w.x); x[8 * k + 1] = bf_hi(w.x); x[8 * k + 2] = bf_lo(w.y); x[8 * k + 3] = bf_hi(w.y);
                x[8 * k + 4] = bf_lo(w.z); x[8 * k + 5] = bf_hi(w.z); x[8 * k + 6] = bf_lo(w.w); x[8 * k + 7] = bf_hi(w.w); }
#pragma unroll
            for (int e = 0; e < 32; ++e) sum += x[e];
            sum += pg8::lane_xor1(sum); sum += pg8::lane_xor2(sum);
            const float mu = sum * (1.0f / 128.0f); float var = 0.f;
#pragma unroll
            for (int e = 0; e < 32; ++e) { x[e] -= mu; var += x[e] * x[e]; }
            var += pg8::lane_xor1(var); var += pg8::lane_xor2(var);
            const float rstd = rsqrtf(var * (1.0f / 128.0f) + 1e-5f);
#pragma unroll
            for (int k = 0; k < 4; ++k) { const f32x4 g0 = lg[2 * k], g1 = lg[2 * k + 1], b0 = lb[2 * k], b1 = lb[2 * k + 1];
                v4u w; w.x = pk2(x[8 * k + 0] * rstd * g0.x + b0.x, x[8 * k + 1] * rstd * g0.y + b0.y); w.y = pk2(x[8 * k + 2] * rstd * g0.z + b0.z, x[8 * k + 3] * rstd * g0.w + b0.w);
                w.z = pk2(x[8 * k + 4] * rstd * g1.x + b1.x, x[8 * k + 5] * rstd * g1.y + b1.y); w.w = pk2(x[8 * k + 6] * rstd * g1.z + b1.z, x[8 * k + 7] * rstd * g1.w + b1.w);
                *(LAS v4u*)(lds + (tid >> 2) * KV_STRIDE + d0 * 2 + 16 * k) = w; }
        }
        v2u uc[8];
#pragma unroll
        for (int p = 0; p < 4; ++p) {
            const auto rx = __builtin_amdgcn_permlane16_swap(P.u[p].x, P.u[p].z, false, false); const auto ry = __builtin_amdgcn_permlane16_swap(P.u[p].y, P.u[p].w, false, false);
            uc[2 * p] = (v2u){rx[0], ry[0]}; uc[2 * p + 1] = (v2u){rx[1], ry[1]}; }
        const int c = (uid >> 3) & 31, b = uid >> 8;
        bf16* op = Z + ((size_t)b * SEQ + 128 * c + t) * INW + 3072 + g * HD + 4 * fq;
        __syncthreads();
        if (uid + G < 1024) gmlp_load(P, Z, uid + G, tid, wave, lane);
        f32x4 acc[8];
#pragma unroll
        for (int dt = 0; dt < 8; ++dt) acc[dt] = (f32x4){0.f, 0.f, 0.f, 0.f};
#pragma unroll
        for (int ks = 0; ks < 4; ++ks) {
            if (ks < nks) {
#pragma unroll
                for (int dt = 0; dt < 8; ++dt) {
                    const s16x4 lo = tr_read(vb + (32 * ks) * KV_STRIDE + 32 * dt);
                    const s16x4 hi = tr_read(vb + (32 * ks + 16) * KV_STRIDE + 32 * dt);
                    const bf16x8 vf = __builtin_shufflevector(lo, hi, 0, 1, 2, 3, 4, 5, 6, 7);
                    acc[dt] = MFMA16(vf, wf[ks], acc[dt]);
                }
            }
        }
        v2u wprev = (v2u){0u, 0u};
#pragma unroll
        for (int dt = 0; dt < 8; ++dt) {
            const v2u uu = uc[dt];
            v2u w; w.x = pk2(bf_lo(uu.x) * (acc[dt][0] + bs), bf_hi(uu.x) * (acc[dt][1] + bs)); w.y = pk2(bf_lo(uu.y) * (acc[dt][2] + bs), bf_hi(uu.y) * (acc[dt][3] + bs));
            if ((dt & 1) == 0) wprev = w;
            else { const auto rx = __builtin_amdgcn_permlane16_swap(wprev.x, w.x, false, false); const auto ry = __builtin_amdgcn_permlane16_swap(wprev.y, w.y, false, false);
                   *(v4u*)(op - 4 * fq + 4 * (fq & ~1) + 16 * (dt - 1 + (fq & 1))) = (v4u){rx[0], ry[0], rx[1], ry[1]}; }
        }
        __syncthreads();
    }
}

__device__ __forceinline__ void combine_rows(const bf16* ON, const float* LSE, bf16* Z, int gw, int NGW, int lane) {
    const int l16 = lane & 15, hq = lane >> 4;
    for (int m = gw; m < M; m += NGW) {
        const int b = m >> 12, t = m & 4095;
#pragma unroll
        for (int it = 0; it < 2; ++it) {
            const int h = 4 * it + hq, bh = b * 8 + h;
            float ls[3]; v4u ov[3];
#pragma unroll
            for (int br = 0; br < 3; ++br) { const int dl = 2 * br; const int pp = (t & ((1 << dl) - 1)) * (SEQ >> dl) + (t >> dl);
                const size_t idx = (size_t)(br * 32 + bh) * SEQ + pp; ls[br] = LSE[idx]; ov[br] = *(const v4u*)(ON + idx * HD + 8 * l16); }
            const float mx = fmaxf(ls[0], fmaxf(ls[1], ls[2]));
            const float w0 = __builtin_amdgcn_exp2f(ls[0] - mx), w1 = __builtin_amdgcn_exp2f(ls[1] - mx), w2 = __builtin_amdgcn_exp2f(ls[2] - mx);
            const float inv = 1.0f / (w0 + w1 + w2);
            const float a0 = w0 * inv, a1 = w1 * inv, a2 = w2 * inv;
            v4u o;
            o.x = pk2(a0 * bf_lo(ov[0].x) + a1 * bf_lo(ov[1].x) + a2 * bf_lo(ov[2].x), a0 * bf_hi(ov[0].x) + a1 * bf_hi(ov[1].x) + a2 * bf_hi(ov[2].x));
            o.y = pk2(a0 * bf_lo(ov[0].y) + a1 * bf_lo(ov[1].y) + a2 * bf_lo(ov[2].y), a0 * bf_hi(ov[0].y) + a1 * bf_hi(ov[1].y) + a2 * bf_hi(ov[2].y));
            o.z = pk2(a0 * bf_lo(ov[0].z) + a1 * bf_lo(ov[1].z) + a2 * bf_lo(ov[2].z), a0 * bf_hi(ov[0].z) + a1 * bf_hi(ov[1].z) + a2 * bf_hi(ov[2].z));
            o.w = pk2(a0 * bf_lo(ov[0].w) + a1 * bf_lo(ov[1].w) + a2 * bf_lo(ov[2].w), a0 * bf_hi(ov[0].w) + a1 * bf_hi(ov[1].w) + a2 * bf_hi(ov[2].w));
            *(v4u*)(Z + (size_t)m * INW + 2048 + h * HD + 8 * l16) = o;
        }
    }
}

typedef __attribute__((address_space(1))) unsigned gu32;
#define RLX_AGENT __ATOMIC_RELAXED, __HIP_MEMORY_SCOPE_AGENT
#define XB_TMO      128
#define XB_XCNT(j)  (256  + 64 * (j))
#define XB_XSUB(j)  (1280 + 64 * (j))
#define XB_XGEN(j)  (2304 + 64 * (j))
#define XB_TOP      3328
#define XB_TOPGEN   3392
#define XCD_BAR_WORDS 3456
#define XB_SPIN_CAP (1u << 18)

__device__ __forceinline__ unsigned xb_ld(unsigned* p)              { return __hip_atomic_load((GAS1 unsigned*)p, __ATOMIC_RELAXED, __HIP_MEMORY_SCOPE_AGENT); }
__device__ __forceinline__ unsigned xb_add(unsigned* p, unsigned v) { return __hip_atomic_fetch_add((GAS1 unsigned*)p, v, __ATOMIC_RELAXED, __HIP_MEMORY_SCOPE_AGENT); }
__device__ __forceinline__ unsigned xb_xcc_id() { return (unsigned)__builtin_amdgcn_s_getreg((3 << 11) | 20) & 0xFu; }
#define XB_SPIN(cond, bar) do { unsigned _sp = 0; while (cond) { __builtin_amdgcn_s_sleep(1); \
    if ((++_sp & 255u) == 0u) { if (xb_ld(&(bar)[XB_TMO])) break; if (_sp > XB_SPIN_CAP) { atomicAdd(&(bar)[XB_TMO], 1u); break; } } } } while (0)

struct XcdBarrier {
    unsigned* bar; unsigned x;
    volatile LAS unsigned* st;
};

__device__ __forceinline__ XcdBarrier xcd_barrier_post(unsigned* bar, volatile LAS unsigned* st) {
    XcdBarrier b; b.bar = bar; b.x = xb_xcc_id(); b.st = st;
    if (threadIdx.x == 0) (void)xb_add(&bar[XB_XCNT(b.x)], 1u);
    return b;
}
__device__ __forceinline__ void xcd_barrier_complete(unsigned* bar, unsigned x, unsigned& nloc, unsigned& nx) {
    const unsigned G = gridDim.x * gridDim.y * gridDim.z;
    unsigned sum, cnt, mine, sp = 0u;
    for (;;) {
        sum = 0u; cnt = 0u; mine = 0u;
#pragma unroll
        for (unsigned j = 0; j < 16; ++j) { const unsigned c = xb_ld(&bar[XB_XCNT(j)]); sum += c; cnt += (c > 0u) ? 1u : 0u; mine = (j == x) ? c : mine; }
        if (sum == G) break;
        __builtin_amdgcn_s_sleep(1);
        if ((++sp & 255u) == 0u) { if (xb_ld(&bar[XB_TMO])) break; if (sp > XB_SPIN_CAP) { atomicAdd(&bar[XB_TMO], 1u); break; } }
    }
    nloc = mine > 0u ? mine : 1u; nx = cnt > 0u ? cnt : 1u;
}

__device__ __forceinline__ void xcd_barrier(const XcdBarrier& b, const int wave) {
    const bool leader = wave == 0 && pg8::fresh_lane() == 0;
    asm volatile("s_waitcnt vmcnt(0)" ::: "memory");
    __syncthreads();
    if (leader) {
        const unsigned bxx = xb_xcc_id();
        unsigned* bar = b.bar; asm volatile("" : "+s"(bar));
        __builtin_amdgcn_s_waitcnt(0);
        const unsigned nloc = b.st[0], nx = b.st[1];
        const unsigned old = xb_add(&bar[XB_XSUB(bxx)], 1u);
        const unsigned gen = old / nloc;
        if (old + 1u == (gen + 1u) * nloc) {
            __builtin_amdgcn_fence(__ATOMIC_RELEASE, "agent");
            asm volatile("s_waitcnt vmcnt(0)" ::: "memory");
            const unsigned og = xb_add(&bar[XB_TOP], 1u);
            const unsigned tg = og / nx;
            if (og + 1u == (tg + 1u) * nx) xb_add(&bar[XB_TOPGEN], 1u);
            else XB_SPIN(xb_ld(&bar[XB_TOPGEN]) == tg, bar);
            __builtin_amdgcn_fence(__ATOMIC_ACQUIRE, "agent");
            xb_add(&bar[XB_XGEN(bxx)], 1u);
            asm volatile("s_waitcnt vmcnt(0)" ::: "memory");
        } else {
            XB_SPIN(xb_ld(&bar[XB_XGEN(bxx)]) == gen, bar);
            __builtin_amdgcn_fence(__ATOMIC_ACQUIRE, "agent");
            asm volatile("s_waitcnt vmcnt(0)" ::: "memory");
        }
    }
    __syncthreads();
}

__global__ void __launch_bounds__(NWAVES * 64, 2) hybrid_fwd(Args a) {
    extern __shared__ __attribute__((aligned(16))) unsigned char lds_raw[];
    cg::grid_group grid = cg::this_grid();
    LAS unsigned char* lds = (LAS unsigned char*)lds_raw;
    const int G = gridDim.x, bx = blockIdx.x, NGW = G * NWAVES;
    const int wave_k = __builtin_amdgcn_readfirstlane((int)threadIdx.x >> 6);
#define FRESH_IDS() int wave = wave_k; asm volatile("" : "+s"(wave)); const int lane = pg8::fresh_lane(); const int tid = wave * 64 + lane; const int gw = bx * NWAVES + wave; (void)gw; (void)tid
    unsigned char* ws = a.ws;
#define WSPTR(T, off) ((T*)(GAS1 T*)({ unsigned char* p_ = a.ws; asm volatile("" : "+s"(p_)); (GAS1 unsigned char*)p_ + (off); }))
#define Wi WSPTR(bf16, WS_WIN)
#define Wo WSPTR(bf16, WS_WOUT)
#define Wu WSPTR(bf16, WS_WUP)
#define Wd WSPTR(bf16, WS_WDN)
#define ACT WSPTR(bf16, WS_ACT)
#define Z WSPTR(bf16, WS_Z)
#define ON WSPTR(bf16, WS_ON)
#define U WSPTR(bf16, WS_U)
#define SS WSPTR(float, WS_SS)
#define LSE WSPTR(float, WS_LSE)
#define ROPE WSPTR(float, WS_ROPE)
#define WSP WSPTR(bf16, WS_WSP)

    unsigned* barw = (unsigned*)(ws + WS_BAR);
    if (bx == 0) for (int i = threadIdx.x; i < XCD_BAR_WORDS; i += NWAVES * 64) barw[i] = 0u;
    volatile LAS unsigned* bst = (volatile LAS unsigned*)(lds + LDS_MAIN);
    {
        FRESH_IDS();
        LAS float* scr = (LAS float*)(lds + wave * 16640);
        constexpr int I_IN = (DM / 64) * (INW / 64), I_OUT = (DM / 64) * (DM / 64), I_UP = (DM / 64) * (DFF / 64), I_DN = (DFF / 64) * (DM / 64);
        constexpr int PER_L = I_IN + I_OUT + I_UP + I_DN;
        for (int it = gw; it < DEPTH * PER_L; it += NGW) {
            const int l = it / PER_L; int r = it % PER_L;
            if (r < I_IN) { p0_transpose_item(a.w_in + (size_t)l * DM * INW, DM, INW, Wi + (size_t)l * INW * DM, r, true, a.norm1_g + l * DM, scr, lane); continue; } r -= I_IN;
            if (r < I_OUT) { p0_transpose_item(a.w_out + (size_t)l * DM * DM, DM, DM, Wo + (size_t)l * DM * DM, r, false, nullptr, scr, lane); continue; } r -= I_OUT;
            if (r < I_UP) { p0_transpose_item(a.w_up + (size_t)l * DM * DFF, DM, DFF, Wu + (size_t)l * DFF * DM, r, false, a.norm2_g + l * DM, scr, lane); continue; } r -= I_UP;
            p0_transpose_item(a.w_down + (size_t)l * DFF * DM, DFF, DM, Wd + (size_t)l * DM * DFF, r, false, nullptr, scr, lane);
        }
        for (int e = bx * 512 + tid; e < SEQ * 64; e += G * 512) { float co, si; rope_entry(e >> 6, e & 63, co, si); ROPE[2 * e] = co; ROPE[2 * e + 1] = si; }
        for (int e = bx * 512 + tid; e < DEPTH * 8 * 128 * 128; e += G * 512) { const int s = e & 127, t = (e >> 7) & 127; const float w = a.w_sp[e]; WSP[e] = (bf16)(pk2(s <= t ? w : 0.f, 0.f) & 0xffffu); }
        cast_rows(a.x, ACT, SS, gw, NGW, lane);
    }
    grid.sync();
    const XcdBarrier bar = xcd_barrier_post(barw, bst);
    if (wave_k == 0 && pg8::fresh_lane() == 0) { unsigned nloc, nx; xcd_barrier_complete(barw, bar.x, nloc, nx); bst[0] = nloc; bst[1] = nx; }
    __syncthreads();

#pragma nounroll
    for (int l = 0; l < DEPTH; ++l) {
        { pg8::Gemm g{ACT, Wi + (size_t)l * INW * DM, M, INW, DM, DM}; pg8::StaticOrder S; S.init(M, INW, G, bx, WGM_IN);
          FRESH_IDS(); const pg8::RsTable rst = pg8::rs_prepass(lds + 131072, SS, S, tid);
          pg8::EpiInProj E{Z, ROPE, rst};
          pg8::gemm_phase<pg8::EpiInProj, pg8::StaticOrder, true, true>(lds, g, S, E, wave_k); }
        xcd_barrier(bar, wave_k);
        {
            FRESH_IDS();
            const int vx = bx & 7, vr = bx >> 3;
            AttnPre P; AttnUid cu = attn_decode_chain(vx, vr, 0);
            attn_load(P, Z, cu, tid, wave, lane);
#pragma nounroll
            for (int idx = 0; idx < 12; ++idx) {
                attn_stage(lds, P, cu, tid);
                bf16x8 qf[4] = {P.q[0], P.q[1], P.q[2], P.q[3]};
                __syncthreads();
                const AttnUid u = cu;
                if (idx + 1 < 12) { cu = attn_decode_chain(vx, vr, idx + 1); attn_load(P, Z, cu, tid, wave, lane); }
                attn_compute(lds, qf, u, ON, LSE, wave, lane);
                __syncthreads();
            }
        }
        { FRESH_IDS(); gmlp_phase(lds, Z, WSP + (size_t)l * 8 * 128 * 128, a.b_sp + l * 1024, a.ln_g + l * 1024, a.ln_b + l * 1024, bx, G, tid, wave, lane); }
        xcd_barrier(bar, wave_k);
        { FRESH_IDS(); combine_rows(ON, LSE, Z, gw, NGW, lane); }
        xcd_barrier(bar, wave_k);
        { pg8::Gemm g{Z + 2048, Wo + (size_t)l * DM * DM, M, DM, DM, INW}; pg8::StaticOrder S; S.init(M, DM, G, bx, WGM_OUT);
          pg8::EpiResid E{a.out, ACT, SS, 0};
          pg8::gemm_phase<pg8::EpiResid, pg8::StaticOrder, true, true>(lds, g, S, E, wave_k); }
        xcd_barrier(bar, wave_k);
        { pg8::Gemm g{ACT, Wu + (size_t)l * DFF * DM, M, DFF, DM, DM}; pg8::StaticOrder S; S.init(M, DFF, G, bx, WGM_UP);
          FRESH_IDS(); const pg8::RsTable rst = pg8::rs_prepass(lds + 131072, SS, S, tid);
          pg8::EpiRelu2 E{U, DFF, rst};
          pg8::gemm_phase<pg8::EpiRelu2, pg8::StaticOrder, true, true>(lds, g, S, E, wave_k); }
        xcd_barrier(bar, wave_k);
        { pg8::Gemm g{U, Wd + (size_t)l * DM * DFF, M, DM, DFF, DFF}; pg8::StaticOrder S; S.init(M, DM, G, bx, WGM_DN);
          pg8::EpiResid E{a.out, ACT, SS, 0};
          pg8::gemm_phase<pg8::EpiResid, pg8::StaticOrder, true, true>(lds, g, S, E, wave_k); }
        xcd_barrier(bar, wave_k);
        if (l + 1 == DEPTH) { FRESH_IDS(); final_tiles(lds, ACT, SS, a.final_g, a.out, G, bx, tid); }
    }
}

#undef Wi
#undef Wo
#undef Wu
#undef Wd
#undef ACT
#undef Z
#undef ON
#undef U
#undef SS
#undef LSE
#undef ROPE
#undef WSP
extern "C" void kernel_launch(void* const* d_in, const int* in_sizes, int n_in, void* d_out, int out_size, void* d_ws, size_t ws_size, hipStream_t stream) {
    static int grid = 0;
    if (grid == 0) {
        if (n_in != 12 || in_sizes[0] != M * DM || out_size != M * DM || ws_size < WS_END) { fprintf(stderr, "kernel_launch: unexpected shapes (n_in %d, ws %zu)\n", n_in, ws_size); grid = -1; return; }
        int dev = 0, cus = 0, per_cu = 0;
        hipGetDevice(&dev); hipDeviceGetAttribute(&cus, hipDeviceAttributeMultiprocessorCount, dev);
        if (hipFuncSetAttribute((const void*)hybrid_fwd, hipFuncAttributeMaxDynamicSharedMemorySize, LDS_BYTES) != hipSuccess) { fprintf(stderr, "kernel_launch: hipFuncSetAttribute failed\n"); grid = -1; return; }
        if (hipOccupancyMaxActiveBlocksPerMultiprocessor(&per_cu, (const void*)hybrid_fwd, NWAVES * 64, LDS_BYTES) != hipSuccess || per_cu < 1) { fprintf(stderr, "kernel_launch: occupancy query says %d\n", per_cu); per_cu = 1; }
        (void)hipGetLastError();
        grid = 256;
        if (cus != 256) fprintf(stderr, "kernel_launch: built for 256 CUs, device has %d\n", cus);
    }
    if (grid < 0) return;
    Args a{};
    a.x = (const float*)d_in[0]; a.norm1_g = (const float*)d_in[1]; a.w_in = (const float*)d_in[2]; a.ln_g = (const float*)d_in[3]; a.ln_b = (const float*)d_in[4];
    a.w_sp = (const float*)d_in[5]; a.b_sp = (const float*)d_in[6]; a.w_out = (const float*)d_in[7]; a.norm2_g = (const float*)d_in[8]; a.w_up = (const float*)d_in[9];
    a.w_down = (const float*)d_in[10]; a.final_g = (const float*)d_in[11]; a.out = (float*)d_out; a.ws = (unsigned char*)d_ws;
    void* args[] = {&a};
    hipError_t e = hipLaunchCooperativeKernel((const void*)hybrid_fwd, dim3(grid), dim3(NWAVES * 64), args, LDS_BYTES, stream);
    if (e != hipSuccess) fprintf(stderr, "cooperative launch failed: %s (grid %d)\n", hipGetErrorString(e), grid);
}
```
